# Optimizing an MI355X kernel written in HIP

```python
import math
import jax, jax.numpy as jnp
from jax import lax
import numpy as np

D_MODEL = 1024
BATCH = 4
SEQ = 4096
DEPTH = 1
DEC_BATCH = 32
DEC_SEQ = 4
PAST_LEN = 16384
PAGE_SIZE = 128

HEAD_DIM = 64
N_MLSTM_HEADS = 8
N_NSA_HEADS = 8
N_KV_HEADS = 2
GQ = N_NSA_HEADS // N_KV_HEADS
MLSTM_W = N_MLSTM_HEADS * HEAD_DIM
NSA_W = N_NSA_HEADS * HEAD_DIM
MIX_WIDTH = MLSTM_W + NSA_W
KV_W = N_KV_HEADS * HEAD_DIM
MLSTM_CHUNK = 64
MLSTM_CONV = 4
CMP_BLOCK = 32
SEL_BLOCK = 64
SEL_TOPK = 16
WINDOW = 512
NSA_QBLOCK = 64
N_BUCKETS = 32
MAX_DISTANCE = 128
D_FF = 2688
FFN_CONV = 3
ALPHA = (2.0 * DEPTH) ** 0.25
BETA = (8.0 * DEPTH) ** -0.25
LN_EPS = 1e-5
IN_SIZES = (2 * MLSTM_W, MLSTM_W, MLSTM_W, N_MLSTM_HEADS, N_MLSTM_HEADS,
            NSA_W, KV_W, KV_W, KV_W, KV_W, KV_W, KV_W, 3 * N_NSA_HEADS)
IN_WIDTH = sum(IN_SIZES)

kernel_name = "hymba_mlstm_nsa_convffn_decode_step"


def split_columns(z):
    out, start = [], 0
    for s in IN_SIZES:
        out.append(z[..., start:start + s])
        start += s
    return out


def layer_norm(x, w, b):
    xf = x.astype(jnp.float32)
    mu = jnp.mean(xf, -1, keepdims=True)
    var = jnp.mean(jnp.square(xf - mu), -1, keepdims=True)
    return ((xf - mu) * lax.rsqrt(var + LN_EPS) * w + b).astype(x.dtype)


def head_norm(h, w):
    mu = jnp.mean(h, -1, keepdims=True)
    var = jnp.mean(jnp.square(h - mu), -1, keepdims=True)
    hn = (h - mu) * lax.rsqrt(var + LN_EPS)
    return hn.reshape(h.shape[:2] + (-1,)) * w


def causal_dwconv(u, prev, w, b):
    k_w = w.shape[0]
    t_len = u.shape[1]
    full = jnp.concatenate([prev.astype(u.dtype), u], axis=1)
    out = b
    for j in range(k_w):
        out = out + full[:, j:j + t_len] * w[j]
    return out, full[:, full.shape[1] - (k_w - 1):]


def masked_softmax(s, mask, axes):
    s = jnp.where(mask, s.astype(jnp.float32), -jnp.inf)
    mx = jnp.max(s, axis=axes, keepdims=True)
    mx = jnp.where(jnp.isfinite(mx), mx, 0.0)
    e = jnp.exp(s - mx)
    den = jnp.sum(e, axis=axes, keepdims=True)
    return e / jnp.maximum(den, 1e-30)


def t5_bucket(dist):
    n = jnp.maximum(dist, 0)
    max_exact = N_BUCKETS // 2
    large = max_exact + (jnp.log(jnp.maximum(n, 1).astype(jnp.float32) / max_exact)
                         / math.log(MAX_DISTANCE / max_exact) * (N_BUCKETS - max_exact)).astype(jnp.int32)
    large = jnp.minimum(large, N_BUCKETS - 1)
    return jnp.where(n < max_exact, n, large)


def head_bias(rel_bias, dist):
    b = rel_bias[t5_bucket(dist)].astype(jnp.float32)
    b = b.reshape(dist.shape + (N_KV_HEADS, GQ))
    return jnp.transpose(b, (2, 3, 0, 1))


def group_bias(rel_bias, dist):
    table = jnp.transpose(rel_bias.reshape(N_BUCKETS, N_KV_HEADS, GQ), (1, 0, 2))
    buckets = t5_bucket(dist)
    b = jax.vmap(lambda tb, bk: tb[bk], in_axes=(0, 1), out_axes=1)(table, buckets)
    return jnp.moveaxis(b, -1, 2).astype(jnp.float32)


def mlstm_chunkwise(q, k, v, ig, lf, c0, n0, m0):
    f32 = jnp.float32
    bsz, t_len, n_h, d = q.shape
    q, k, v, ig, lf = (a.astype(f32) for a in (q, k, v, ig, lf))
    k = k * (d ** -0.5)
    c_len = MLSTM_CHUNK if t_len % MLSTM_CHUNK == 0 else t_len
    n_c = t_len // c_len

    def to_chunks(a):
        return jnp.moveaxis(a.reshape((bsz, n_c, c_len) + a.shape[2:]), 1, 0)

    causal = jnp.tril(jnp.ones((c_len, c_len), bool))

    def step(carry, xs):
        c_st, n_st, m_st = carry
        qc, kc, vc, ic, fc = xs
        b = jnp.moveaxis(jnp.cumsum(fc, axis=1), 2, 1)
        ih = jnp.moveaxis(ic, 2, 1)
        dmat = jnp.where(causal, b[..., :, None] - b[..., None, :] + ih[..., None, :], -jnp.inf)
        inter = b + m_st[..., None]
        m_t = jnp.maximum(inter, jnp.max(dmat, -1))
        w_intra = jnp.exp(dmat - m_t[..., None])
        w_inter = jnp.exp(inter - m_t)
        a = w_intra * jnp.einsum('blhd,bshd->bhls', qc, kc)
        num = (jnp.einsum('bhls,bshd->blhd', a, vc)
               + jnp.einsum('bhed,blhd->blhe', c_st, qc) * jnp.moveaxis(w_inter, 1, 2)[..., None])
        den = jnp.sum(a, -1) + w_inter * jnp.einsum('bhd,blhd->bhl', n_st, qc)
        den = jnp.maximum(jnp.abs(den), jnp.exp(-m_t))
        h = num / jnp.moveaxis(den, 1, 2)[..., None]
        b_end = b[..., -1]
        dec = b_end[..., None] - b + ih
        m_new = jnp.maximum(b_end + m_st, jnp.max(dec, -1))
        wk = jnp.exp(dec - m_new[..., None])
        sc = jnp.exp(b_end + m_st - m_new)
        c_new = sc[..., None, None] * c_st + jnp.einsum('bhl,blhe,blhd->bhed', wk, vc, kc)
        n_new = sc[..., None] * n_st + jnp.einsum('bhl,blhd->bhd', wk, kc)
        return (c_new, n_new, m_new), h

    carry0 = (c0.astype(f32), n0.astype(f32), m0.astype(f32))
    (c_f, n_f, m_f), hs = lax.scan(step, carry0, tuple(to_chunks(a) for a in (q, k, v, ig, lf)))
    h = jnp.moveaxis(hs, 0, 1).reshape(bsz, t_len, n_h, d)
    return h, c_f, n_f, m_f


def nsa_attend(q, q_pos0, kv_all, win_all, w_pos0, pool_w, rel_bias):
    bsz, t_q = q.shape[:2]
    t_k = kv_all.shape[1]
    qg = (q.astype(jnp.float32) * HEAD_DIM ** -0.5).reshape(bsz, t_q, N_KV_HEADS, GQ, HEAD_DIM)
    n_cmp = t_k // CMP_BLOCK
    cmp_rows = kv_all[:, :n_cmp * CMP_BLOCK, :2].reshape(bsz, n_cmp, CMP_BLOCK, 2, N_KV_HEADS, HEAD_DIM)
    kv_cmp = jnp.einsum('bcjegd,ejg->ebcgd', cmp_rows, pool_w)
    k_cmp, v_cmp = kv_cmp[0], kv_cmp[1]
    cmp_end = jnp.arange(n_cmp) * CMP_BLOCK + (CMP_BLOCK - 1)
    n_sel = -(-t_k // SEL_BLOCK)
    sel_rows = jnp.pad(kv_all[:, :, 2:], ((0, 0), (0, n_sel * SEL_BLOCK - t_k), (0, 0), (0, 0), (0, 0)))
    sel_blocks = jnp.transpose(sel_rows.reshape(bsz, n_sel, SEL_BLOCK, 2, N_KV_HEADS, HEAD_DIM),
                               (0, 4, 1, 2, 3, 5))
    top_k = min(SEL_TOPK, n_sel)
    ratio = SEL_BLOCK // CMP_BLOCK
    win_pad = jnp.pad(win_all, ((0, 0), (WINDOW, 0), (0, 0), (0, 0), (0, 0)))
    qb_len = NSA_QBLOCK if t_q % NSA_QBLOCK == 0 else t_q
    gather = jax.vmap(jax.vmap(lambda blocks, idx: blocks[idx]))

    def one_block(i):
        qs = i * qb_len
        qb = lax.dynamic_slice_in_dim(qg, qs, qb_len, axis=1)
        t0 = q_pos0 + qs
        t = t0 + jnp.arange(qb_len)
        dist_c = t[:, None] - cmp_end[None, :]
        s_c = jnp.einsum('bqgjd,bcgd->bgjqc', qb, k_cmp) + head_bias(rel_bias, dist_c)
        p_c = masked_softmax(s_c, dist_c >= 0, (-1,))
        o_c = jnp.einsum('bgjqc,bcgd->bqgjd', p_c, v_cmp)
        imp = jnp.pad(jnp.sum(p_c, 2), ((0, 0), (0, 0), (0, 0), (0, n_sel * ratio - n_cmp)))
        imp = imp.reshape(bsz, N_KV_HEADS, qb_len, n_sel, ratio).sum(-1)
        blk = jnp.arange(n_sel)[None, :]
        cur = (t // SEL_BLOCK)[:, None]
        score = jnp.where(blk == cur, jnp.inf, jnp.where(blk < cur, imp, -jnp.inf))
        top_s, top_i = lax.top_k(score, top_k)
        kv_sel = gather(sel_blocks, top_i)
        key_pos = top_i[..., None] * SEL_BLOCK + jnp.arange(SEL_BLOCK)
        dist_s = t[:, None, None] - key_pos
        mask_s = (top_s > -jnp.inf)[..., None] & (dist_s >= 0)
        s_s = jnp.einsum('bqgjd,bgqksd->bgjqks', qb, kv_sel[..., 0, :]) + group_bias(rel_bias, dist_s)
        p_s = masked_softmax(s_s, mask_s[:, :, None], (-2, -1))
        o_s = jnp.einsum('bgjqks,bgqksd->bqgjd', p_s, kv_sel[..., 1, :])
        kv_w = lax.dynamic_slice_in_dim(win_pad, t0 - w_pos0, WINDOW + qb_len, axis=1)
        wpos = t0 - WINDOW + jnp.arange(WINDOW + qb_len)
        dist_w = t[:, None] - wpos[None, :]
        mask_w = (dist_w >= 0) & (dist_w <= WINDOW) & (wpos[None, :] >= w_pos0)
        s_w = jnp.einsum('bqgjd,bsgd->bgjqs', qb, kv_w[:, :, 0]) + head_bias(rel_bias, dist_w)
        p_w = masked_softmax(s_w, mask_w, (-1,))
        o_w = jnp.einsum('bgjqs,bsgd->bqgjd', p_w, kv_w[:, :, 1])
        return o_c, o_s, o_w

    outs = lax.map(one_block, jnp.arange(t_q // qb_len))

    def unblock(o):
        return jnp.moveaxis(o, 0, 1).reshape(bsz, t_q, N_NSA_HEADS, HEAD_DIM)

    return unblock(outs[0]), unblock(outs[1]), unblock(outs[2])


def hybrid_layer(x, pos0, kv_past, win_past, c0, n0, m0, mconv_prev, fconv_prev,
                 w_in, b_in, mlstm_conv_w, mlstm_conv_b, mlstm_norm_w, nsa_pool_w, rel_bias,
                 w_out, ln1_w, ln1_b, w_up, b_up, ffn_conv_w, ffn_conv_b, w_down, b_down, ln2_w, ln2_b):
    bsz, t_len, _ = x.shape
    z = jnp.einsum('btd,de->bte', x, w_in) + b_in
    m_qk, m_v, m_o, m_i, m_f, n_q, c_k, c_v, s_k, s_v, w_k, w_v, n_g = split_columns(z)
    qk, mconv_new = causal_dwconv(m_qk, mconv_prev, mlstm_conv_w, mlstm_conv_b)
    qk = jax.nn.silu(qk)
    hm = lambda a: a.reshape(bsz, t_len, N_MLSTM_HEADS, HEAD_DIM)
    h, c_new, n_new, m_new = mlstm_chunkwise(hm(qk[..., :MLSTM_W]), hm(qk[..., MLSTM_W:]), hm(m_v),
                                             m_i, jax.nn.log_sigmoid(m_f.astype(jnp.float32)), c0, n0, m0)
    mix_m = jax.nn.sigmoid(m_o.astype(jnp.float32)) * head_norm(h, mlstm_norm_w)
    hk = lambda a: a.reshape(bsz, t_len, N_KV_HEADS, HEAD_DIM)
    kv_new = jnp.stack([hk(c_k), hk(c_v), hk(s_k), hk(s_v)], axis=2)
    win_new = jnp.stack([hk(w_k), hk(w_v)], axis=2)
    kv_all = kv_new if kv_past is None else jnp.concatenate([kv_past.astype(kv_new.dtype), kv_new], axis=1)
    win_all = win_new if win_past is None else jnp.concatenate([win_past.astype(win_new.dtype), win_new], axis=1)
    w_pos0 = pos0 + t_len - win_all.shape[1]
    o_c, o_s, o_w = nsa_attend(n_q.reshape(bsz, t_len, N_NSA_HEADS, HEAD_DIM), pos0, kv_all, win_all,
                               w_pos0, nsa_pool_w, rel_bias)
    g = jax.nn.sigmoid(n_g.astype(jnp.float32)).reshape(bsz, t_len, 3, N_NSA_HEADS)[..., None]
    mix_n = (g[:, :, 0] * o_c + g[:, :, 1] * o_s + g[:, :, 2] * o_w).reshape(bsz, t_len, NSA_W)
    mix = jnp.concatenate([mix_m, mix_n], axis=-1).astype(x.dtype)
    x1 = layer_norm(ALPHA * x + mix @ w_out, ln1_w, ln1_b)
    u, fconv_new = causal_dwconv(x1 @ w_up + b_up, fconv_prev, ffn_conv_w, ffn_conv_b)
    ff = (jax.nn.gelu(u[..., :D_FF]) * u[..., D_FF:]) @ w_down + b_down
    y = layer_norm(ALPHA * x1 + ff, ln2_w, ln2_b)
    win_state = win_all[:, win_all.shape[1] - min(WINDOW, pos0 + t_len):]
    return y, kv_new, win_state, c_new, n_new, m_new, mconv_new, fconv_new


def setup_inputs(seed: int = 0) -> dict:
    key = jax.random.key(seed)
    ks = jax.random.split(key, 32)
    nrm = lambda i, shape: jax.random.normal(ks[i], shape, jnp.float32)
    n_pages = PAST_LEN // PAGE_SIZE
    n_used = DEC_BATCH * n_pages
    n_pool = n_used + max(n_used // 4, 1)
    win_buf = min(WINDOW, PAST_LEN)
    page_table = jax.random.permutation(ks[0], n_pool)[:n_used].reshape(DEC_BATCH, n_pages).astype(jnp.int32)
    f_start = 2 * MLSTM_W + 2 * MLSTM_W + N_MLSTM_HEADS
    b_in = 0.02 * nrm(1, (IN_WIDTH,))
    b_in = b_in.at[f_start:f_start + N_MLSTM_HEADS].add(jnp.linspace(3.0, 6.0, N_MLSTM_HEADS))
    return {
        'x_prompt': nrm(2, (BATCH, SEQ, D_MODEL)),
        'x_sample': nrm(3, (DEC_BATCH, DEC_SEQ, D_MODEL)),
        'cache_nsa_kv': nrm(4, (n_pool, PAGE_SIZE, 4, N_KV_HEADS, HEAD_DIM)),
        'cache_win_kv': nrm(5, (DEC_BATCH, win_buf, 2, N_KV_HEADS, HEAD_DIM)),
        'state_mlstm_c': 0.3 * nrm(6, (DEC_BATCH, N_MLSTM_HEADS, HEAD_DIM, HEAD_DIM)),
        'state_mlstm_n': 0.3 * nrm(7, (DEC_BATCH, N_MLSTM_HEADS, HEAD_DIM)),
        'state_mlstm_m': nrm(8, (DEC_BATCH, N_MLSTM_HEADS)),
        'state_mlstm_conv': nrm(9, (DEC_BATCH, MLSTM_CONV - 1, 2 * MLSTM_W)),
        'state_ffn_conv': nrm(10, (DEC_BATCH, FFN_CONV - 1, 2 * D_FF)),
        'page_table': page_table,
        'w_in': nrm(11, (D_MODEL, IN_WIDTH)) * D_MODEL ** -0.5,
        'b_in': b_in,
        'mlstm_conv_w': nrm(12, (MLSTM_CONV, 2 * MLSTM_W)) * MLSTM_CONV ** -0.5,
        'mlstm_conv_b': 0.02 * nrm(13, (2 * MLSTM_W,)),
        'mlstm_norm_w': 1.0 + 0.02 * nrm(14, (MLSTM_W,)),
        'nsa_pool_w': CMP_BLOCK ** -0.5 * (1.0 + 0.1 * nrm(15, (2, CMP_BLOCK, N_KV_HEADS))),
        'rel_bias': 0.1 * nrm(16, (N_BUCKETS, N_NSA_HEADS)),
        'w_out': nrm(17, (MIX_WIDTH, D_MODEL)) * MIX_WIDTH ** -0.5 * BETA,
        'ln1_w': 1.0 + 0.02 * nrm(18, (D_MODEL,)),
        'ln1_b': 0.02 * nrm(19, (D_MODEL,)),
        'w_up': nrm(20, (D_MODEL, 2 * D_FF)) * D_MODEL ** -0.5,
        'b_up': 0.02 * nrm(21, (2 * D_FF,)),
        'ffn_conv_w': nrm(22, (FFN_CONV, 2 * D_FF)) * FFN_CONV ** -0.5,
        'ffn_conv_b': 0.02 * nrm(23, (2 * D_FF,)),
        'w_down': nrm(24, (D_FF, D_MODEL)) * D_FF ** -0.5 * BETA,
        'b_down': 0.02 * nrm(25, (D_MODEL,)),
        'ln2_w': 1.0 + 0.02 * nrm(26, (D_MODEL,)),
        'ln2_b': 0.02 * nrm(27, (D_MODEL,)),
    }


def reference(x_prompt, x_sample, cache_nsa_kv, cache_win_kv, state_mlstm_c, state_mlstm_n, state_mlstm_m,
              state_mlstm_conv, state_ffn_conv, page_table,
              w_in, b_in, mlstm_conv_w, mlstm_conv_b, mlstm_norm_w, nsa_pool_w, rel_bias, w_out,
              ln1_w, ln1_b, w_up, b_up, ffn_conv_w, ffn_conv_b, w_down, b_down, ln2_w, ln2_b):
    weights = (w_in, b_in, mlstm_conv_w, mlstm_conv_b, mlstm_norm_w, nsa_pool_w, rel_bias, w_out,
               ln1_w, ln1_b, w_up, b_up, ffn_conv_w, ffn_conv_b, w_down, b_down, ln2_w, ln2_b)
    bsz = x_prompt.shape[0]
    f32 = jnp.float32
    for _layer in range(DEPTH):
        (y_p, kv_p, win_p, c_p, n_p, m_p, mconv_p, fconv_p) = hybrid_layer(
            x_prompt, 0, None, None,
            jnp.zeros((bsz, N_MLSTM_HEADS, HEAD_DIM, HEAD_DIM), f32),
            jnp.zeros((bsz, N_MLSTM_HEADS, HEAD_DIM), f32),
            jnp.zeros((bsz, N_MLSTM_HEADS), f32),
            jnp.zeros((bsz, MLSTM_CONV - 1, 2 * MLSTM_W), x_prompt.dtype),
            jnp.zeros((bsz, FFN_CONV - 1, 2 * D_FF), x_prompt.dtype),
            *weights)
    dec_b, n_pages = page_table.shape
    kv_past = cache_nsa_kv[page_table].reshape(dec_b, n_pages * PAGE_SIZE, 4, N_KV_HEADS, HEAD_DIM)
    past_len = n_pages * PAGE_SIZE
    for _layer in range(DEPTH):
        (y_s, kv_s, win_s, c_s, n_s, m_s, mconv_s, fconv_s) = hybrid_layer(
            x_sample, past_len, kv_past, cache_win_kv, state_mlstm_c, state_mlstm_n, state_mlstm_m,
            state_mlstm_conv, state_ffn_conv, *weights)
    return (y_p, y_s, kv_p, kv_s, win_p, win_s, c_p, c_s, n_p, n_s, m_p, m_s, mconv_p, mconv_s, fconv_p, fconv_s)
```

```cpp
#include <hip/hip_runtime.h>
#include <cstdio>
#include <cstdint>
namespace pg8 {
#define PG8_LAS __attribute__((address_space(3)))
typedef unsigned short bf16_t;
typedef short bf16x8 __attribute__((ext_vector_type(8)));
typedef float f32x4 __attribute__((ext_vector_type(4)));
typedef unsigned u32x4 __attribute__((ext_vector_type(4)));
constexpr int BM = 256, BK = 64, HALF = 128, HTB = HALF * BK * 2  , STAGE_BYTES = 8 * HTB, NXCD = 8, WGM = 8;

__host__ __device__ __forceinline__ int lds_byte(int r, int c) { const int st = (r >> 4) * 2 + (c >> 5), rr = r & 15, cc = c & 31, ob = rr * 64 + cc * 2; return st * 1024 + (ob ^ (((ob >> 9) & 1) << 5)); }
__host__ __device__ __forceinline__ void stage_rc(int b, int& R, int& C) { const int st = b / 1024, sb = b % 1024, swz = sb ^ (((sb >> 9) & 1) << 5); R = (st >> 1) * 16 + swz / 64; C = (st & 1) * 32 + (swz % 64) / 2; }
__host__ __device__ __forceinline__ int perm32(int rho) { const int n = rho >> 4, i = rho & 15; return 8 * (i >> 2) + 4 * n + (i & 3); }

struct Unit { int pm, pn; };
struct Gemm { const bf16_t* A; const bf16_t* Bt; int M, N, K; };

struct StaticOrder {
    int nM, nN, nwg, G, c;
    __host__ __device__ void init(int M, int N, int G_, int c_) { nM = M / BM; nN = N / BM; nwg = nM * nN; G = G_; c = c_; }
    __host__ __device__ bool next(int i, Unit& u) const {
        const long L = (long)i * G + c; if (L >= nwg) return false;
        int wgid = (int)L; { const int q = nwg / NXCD, r = nwg % NXCD, xcd = wgid % NXCD, off = wgid / NXCD; wgid = (xcd < r ? xcd * (q + 1) : r * (q + 1) + (xcd - r) * q) + off; }
        const int nig = WGM * nN, gid = wgid / nig, fm = gid * WGM, gsz = (nM - fm) < WGM ? (nM - fm) : WGM;
        u.pm = fm + ((wgid % nig) % gsz); u.pn = (wgid % nig) / gsz; return true;
    }
    __device__ __forceinline__ void a_ready(const Unit&) const {}
    __device__ __forceinline__ void done(const Unit&) const {}
};

__device__ __forceinline__ unsigned cvt_pk_bf16(float lo, float hi) { unsigned r; asm volatile("v_cvt_pk_bf16_f32 %0, %1, %2" : "=v"(r) : "v"(lo), "v"(hi)); return r; }
typedef float f32x2 __attribute__((ext_vector_type(2)));
__device__ __forceinline__ f32x2 gelu_pk(f32x2 v) {
    const f32x2 av = __builtin_elementwise_abs(v), d = av * 0.2316418882f + 1.0f;
    f32x2 t; t.x = __builtin_amdgcn_rcpf(d.x); t.y = __builtin_amdgcn_rcpf(d.y);
    f32x2 q = t * 0.5307027145f + (-0.7265760135f); q = q * t + 0.7107068705f; q = q * t + (-0.142248368f); q = q * t + 0.127414796f; q = q * t;
    const f32x2 s = (v * v) * (-0.72134752044f);
    f32x2 e; e.x = __builtin_amdgcn_exp2f(s.x); e.y = __builtin_amdgcn_exp2f(s.y);
    const f32x2 m = v * (q * e), r = v - m;
    f32x2 o; o.x = v.x < 0.f ? m.x : r.x; o.y = v.y < 0.f ? m.y : r.y; return o;
}

template <int ACT  > struct EpiBf16 {
    static constexpr bool PERM = true, AFTER_DRAIN = false; static_assert(ACT == 0 || ACT == 1, "EpiBf16: ACT is 0 (none) or 1 (gelu_pk)");
    bf16_t* O; int ldc; const float* bias; int split_cols; size_t split_stride; float scale0;
    __device__ __forceinline__ void operator()(const f32x4 (&acc)[2][2][4][2], const Unit& u, int wr, int wc, int fr, int fq) const {
        const int row0 = u.pm * BM + wr * 64 + fr; int colt = u.pn * BM; bf16_t* base = O;
        float sc = 1.f; if (split_cols) { const int t = colt / split_cols; base += (size_t)t * split_stride; colt -= t * split_cols; if (t == 0) sc = scale0; }
        const int col0 = colt + wc * 32 + 8 * fq, bcol0 = u.pn * BM + wc * 32 + 8 * fq;
        f32x4 bv[2][2];
#pragma unroll
        for (int bj = 0; bj < 2; ++bj)
#pragma unroll
            for (int n = 0; n < 2; ++n) bv[bj][n] = bias ? *(const f32x4*)(bias + bcol0 + bj * HALF + 4 * n) : (f32x4){0.f, 0.f, 0.f, 0.f};
#pragma unroll
        for (int ai = 0; ai < 2; ++ai)
#pragma unroll
            for (int m = 0; m < 4; ++m) { bf16_t* rowp = base + (size_t)(row0 + ai * HALF + m * 16) * ldc + col0;
#pragma unroll
                for (int bj = 0; bj < 2; ++bj) { f32x4 v0 = acc[ai][bj][m][0] + bv[bj][0], v1 = acc[ai][bj][m][1] + bv[bj][1];
                    if (ACT == 1) { f32x2 a = gelu_pk((f32x2){v0[0], v0[1]}), b = gelu_pk((f32x2){v0[2], v0[3]}), c = gelu_pk((f32x2){v1[0], v1[1]}), d = gelu_pk((f32x2){v1[2], v1[3]});
                        v0 = (f32x4){a.x, a.y, b.x, b.y}; v1 = (f32x4){c.x, c.y, d.x, d.y}; }
                    v0 = v0 * sc; v1 = v1 * sc; u32x4 w; w.x = cvt_pk_bf16(v0[0], v0[1]); w.y = cvt_pk_bf16(v0[2], v0[3]); w.z = cvt_pk_bf16(v1[0], v1[1]); w.w = cvt_pk_bf16(v1[2], v1[3]);
                    *(u32x4*)(rowp + bj * HALF) = w; } }
    }
};

struct PanelStats {
    unsigned* xbuf;
    unsigned* cnt;
    unsigned* tmo;
    int ntn; float eps;
    unsigned code;
    __device__ __forceinline__ bool run(const f32x4 (&v)[2][2][4][2], const Unit& u, int wr, int wc, int fr, int fq, PG8_LAS unsigned char* lds, int wid, int lane) const {
        typedef float f32x2v __attribute__((ext_vector_type(2)));
        PG8_LAS f32x2v* P = (PG8_LAS f32x2v*)lds;
        PG8_LAS f32x2v* S = (PG8_LAS f32x2v*)(lds + 8192);
        PG8_LAS unsigned* flag = (PG8_LAS unsigned*)(lds + 8192 + 2048);
#pragma unroll
        for (int ai = 0; ai < 2; ++ai)
#pragma unroll
            for (int m = 0; m < 4; ++m) {
                float s = 0.f;
#pragma unroll
                for (int bj = 0; bj < 2; ++bj)
#pragma unroll
                    for (int n = 0; n < 2; ++n) { const f32x4 x = v[ai][bj][m][n]; s += (x[0] + x[1]) + (x[2] + x[3]); }
                s += __shfl_xor(s, 16); s += __shfl_xor(s, 32);
                const float mw = s * (1.0f / 64.0f); float q = 0.f;
#pragma unroll
                for (int bj = 0; bj < 2; ++bj)
#pragma unroll
                    for (int n = 0; n < 2; ++n) { const f32x4 d = v[ai][bj][m][n] - mw; q += (d[0] * d[0] + d[1] * d[1]) + (d[2] * d[2] + d[3] * d[3]); }
                q += __shfl_xor(q, 16); q += __shfl_xor(q, 32);
                if (fq == 0) P[(ai * HALF + wr * 64 + m * 16 + fr) * 4 + wc] = (f32x2v){mw, q};
            }
        asm volatile("s_waitcnt lgkmcnt(0)" ::: "memory"); __builtin_amdgcn_s_barrier(); asm volatile("" ::: "memory");
#if defined(BROKEN_EXCHANGE_NO_WAIT)
#warning BROKEN CONTROL BUILD: the row-statistics exchange does not wait; results are wrong by design
        if (blockIdx.x >= 64) { const long long t0_ = clock64(); while (clock64() - t0_ < 60000) __builtin_amdgcn_s_sleep(8); }
#endif
        const int row = wid * 32 + (lane & 31);
        if (lane < 32) {
            const f32x2v a = P[row * 4 + 0], b = P[row * 4 + 1], c = P[row * 4 + 2], d = P[row * 4 + 3];
            const float mt = (a.x + b.x + c.x + d.x) * 0.25f;
            const float da = a.x - mt, db = b.x - mt, dc = c.x - mt, dd = d.x - mt;
            const float m2 = (a.y + b.y) + (c.y + d.y) + 64.0f * ((da * da + db * db) + (dc * dc + dd * dd));
            unsigned long long* slot = (unsigned long long*)xbuf + ((size_t)(u.pm * BM + row) * 4 + u.pn);
            __hip_atomic_store(slot, ((unsigned long long)__float_as_uint(m2) << 32) | __float_as_uint(mt), __ATOMIC_RELAXED, __HIP_MEMORY_SCOPE_AGENT);
        }
        asm volatile("s_waitcnt vmcnt(0)" ::: "memory");
        if (lane == 0) __hip_atomic_fetch_add(cnt + 64 * u.pm, 1u, __ATOMIC_RELAXED, __HIP_MEMORY_SCOPE_AGENT);
        if (wid == 0) {
            bool dead = false; const unsigned long long t0 = __builtin_amdgcn_s_memrealtime(); const unsigned want = 8u * (unsigned)ntn;
            for (;;) {
#if defined(BROKEN_EXCHANGE_NO_WAIT)
                break;
#endif
                if ((unsigned)__builtin_amdgcn_readfirstlane(__hip_atomic_load(cnt + 64 * u.pm, __ATOMIC_RELAXED, __HIP_MEMORY_SCOPE_AGENT)) >= want) break;
                if (__builtin_amdgcn_s_memrealtime() - t0 > 2000000ull) {
                    if (lane == 0) { unsigned expect = 0u; __hip_atomic_compare_exchange_strong(tmo + 1, &expect, code | (unsigned)(u.pm & 0xff), __ATOMIC_RELAXED, __ATOMIC_RELAXED, __HIP_MEMORY_SCOPE_AGENT);
                                     __hip_atomic_store(tmo, 1u, __ATOMIC_RELAXED, __HIP_MEMORY_SCOPE_AGENT); }
                    dead = true; break; }
                __builtin_amdgcn_s_sleep(2);
            }
            __builtin_amdgcn_fence(__ATOMIC_ACQUIRE, "agent");
            if (lane == 0) flag[0] = dead ? 1u : 0u;
        }
        asm volatile("s_waitcnt vmcnt(0) lgkmcnt(0)" ::: "memory"); __builtin_amdgcn_s_barrier(); asm volatile("" ::: "memory");
        const bool bad = flag[0] != 0u;
        if (lane < 32) {
            const unsigned long long* slot = (const unsigned long long*)xbuf + (size_t)(u.pm * BM + row) * 4; float mt[4], m2[4]; float ms = 0.f;
#pragma unroll
            for (int t = 0; t < 4; ++t) { if (t < ntn) { const unsigned long long w = __hip_atomic_load(slot + t, __ATOMIC_RELAXED, __HIP_MEMORY_SCOPE_AGENT); mt[t] = __uint_as_float((unsigned)w); m2[t] = __uint_as_float((unsigned)(w >> 32)); } else { mt[t] = 0.f; m2[t] = 0.f; } ms += mt[t]; }
            const float mean = ms / (float)ntn; float q = 0.f;
#pragma unroll
            for (int t = 0; t < 4; ++t) if (t < ntn) { const float dm = mt[t] - mean; q += m2[t] + 256.0f * dm * dm; }
            S[row] = (f32x2v){mean, 1.0f / sqrtf(q / (256.0f * (float)ntn) + eps)};
        }
        asm volatile("s_waitcnt lgkmcnt(0)" ::: "memory"); __builtin_amdgcn_s_barrier(); asm volatile("" ::: "memory");
        return bad;
    }
};
struct EpiLnRes {
    static constexpr bool PERM = false, AFTER_DRAIN = true;
    const float* base; float* out; int ldc; const float* bias; PanelStats st; unsigned poison;
    __device__ __forceinline__ void fused(f32x4 (&acc)[2][2][4][2], const Unit& u, int wr, int wc, int fr, int fq, PG8_LAS unsigned char* lds, int wid, int lane) const {
        typedef float f32x2v __attribute__((ext_vector_type(2)));
        const PG8_LAS f32x2v* S = (const PG8_LAS f32x2v*)(lds + 8192);
        const int col0 = u.pn * BM + wc * 32 + 4 * fq;
#pragma unroll
        for (int bj = 0; bj < 2; ++bj)
#pragma unroll
            for (int n = 0; n < 2; ++n) { const f32x4 bv = bias ? *(const f32x4*)(bias + col0 + bj * HALF + n * 16) : (f32x4){0.f, 0.f, 0.f, 0.f};
#pragma unroll
                for (int ai = 0; ai < 2; ++ai)
#pragma unroll
                    for (int m = 0; m < 4; ++m) acc[ai][bj][m][n] += bv; }
        f32x4 pre[4][2][2];
#pragma unroll
        for (int m = 0; m < 4; ++m) { const size_t off = (size_t)(u.pm * BM + wr * 64 + m * 16 + fr) * ldc + col0;
#pragma unroll
            for (int bj = 0; bj < 2; ++bj)
#pragma unroll
                for (int n = 0; n < 2; ++n) pre[m][bj][n] = *(const f32x4*)(base + off + bj * HALF + n * 16); }
        const bool bad = st.run(acc, u, wr, wc, fr, fq, lds, wid, lane) || poison != 0u;
        const float qnan = __builtin_nanf("");
#pragma unroll
        for (int ai = 0; ai < 2; ++ai)
#pragma unroll
            for (int m = 0; m < 4; ++m) { const int r = ai * HALF + wr * 64 + m * 16 + fr; const f32x2v sr = S[r]; const size_t off = (size_t)(u.pm * BM + r) * ldc + col0;
#pragma unroll
                for (int bj = 0; bj < 2; ++bj)
#pragma unroll
                    for (int n = 0; n < 2; ++n) { const f32x4 bs = ai == 0 ? pre[m][bj][n] : *(const f32x4*)(base + off + bj * HALF + n * 16); f32x4 o = bs + (acc[ai][bj][m][n] - sr.x) * sr.y;
                        if (bad) o = (f32x4){qnan, qnan, qnan, qnan}; *(f32x4*)(out + off + bj * HALF + n * 16) = o; }
                if (m & 1) asm volatile("" ::: "memory"); }
    }
};
struct EpiLnResLn {
    static constexpr bool PERM = false, AFTER_DRAIN = true;
    const float* base; float* out; bf16_t* xn; int ldc; const float* bias; PanelStats st1, st2; unsigned poison;
    __device__ __forceinline__ void fused(f32x4 (&acc)[2][2][4][2], const Unit& u, int wr, int wc, int fr, int fq, PG8_LAS unsigned char* lds, int wid, int lane) const {
        typedef float f32x2v __attribute__((ext_vector_type(2))); typedef unsigned u32x2v __attribute__((ext_vector_type(2)));
        const PG8_LAS f32x2v* S = (const PG8_LAS f32x2v*)(lds + 8192);
        const int col0 = u.pn * BM + wc * 32 + 4 * fq;
#pragma unroll
        for (int bj = 0; bj < 2; ++bj)
#pragma unroll
            for (int n = 0; n < 2; ++n) { const f32x4 bv = bias ? *(const f32x4*)(bias + col0 + bj * HALF + n * 16) : (f32x4){0.f, 0.f, 0.f, 0.f};
#pragma unroll
                for (int ai = 0; ai < 2; ++ai)
#pragma unroll
                    for (int m = 0; m < 4; ++m) acc[ai][bj][m][n] += bv; }
        bool bad = st1.run(acc, u, wr, wc, fr, fq, lds, wid, lane) || poison != 0u;
        const float qnan = __builtin_nanf("");
#pragma unroll
        for (int ai = 0; ai < 2; ++ai)
#pragma unroll
            for (int m = 0; m < 4; ++m) { const int r = ai * HALF + wr * 64 + m * 16 + fr; const f32x2v sr = S[r]; const size_t off = (size_t)(u.pm * BM + r) * ldc + col0;
#pragma unroll
                for (int bj = 0; bj < 2; ++bj)
#pragma unroll
                    for (int n = 0; n < 2; ++n) { const f32x4 bs = *(const f32x4*)(base + off + bj * HALF + n * 16); acc[ai][bj][m][n] = bs + (acc[ai][bj][m][n] - sr.x) * sr.y; }
                asm volatile("" : "+v"(acc[ai][0][m][0]), "+v"(acc[ai][0][m][1]), "+v"(acc[ai][1][m][0]), "+v"(acc[ai][1][m][1]));
                if (m & 1) asm volatile("" ::: "memory"); }
        const bool bad1 = bad;
        bad = st2.run(acc, u, wr, wc, fr, fq, lds, wid, lane) || bad;
#pragma unroll
        for (int ai = 0; ai < 2; ++ai)
#pragma unroll
            for (int m = 0; m < 4; ++m) { const int r = ai * HALF + wr * 64 + m * 16 + fr; const f32x2v sr = S[r]; const size_t off = (size_t)(u.pm * BM + r) * ldc + col0;
#pragma unroll
                for (int bj = 0; bj < 2; ++bj)
#pragma unroll
                    for (int n = 0; n < 2; ++n) { const f32x4 x1 = acc[ai][bj][m][n]; *(f32x4*)(out + off + bj * HALF + n * 16) = bad1 ? (f32x4){qnan, qnan, qnan, qnan} : x1;
                        const f32x4 o = (x1 - sr.x) * sr.y; u32x2v w; w.x = cvt_pk_bf16(o[0], o[1]); w.y = cvt_pk_bf16(o[2], o[3]);
                        if (bad) { w.x = 0x7fc07fc0u; w.y = 0x7fc07fc0u; } *(u32x2v*)(xn + off + bj * HALF + n * 16) = w; }
                asm volatile("" ::: "memory"); }
    }
};

template <class Epi, class Sched, bool ALIGN_EPI = false, bool SP2 = false>
__device__ __forceinline__ void gemm_phase(PG8_LAS unsigned char* lds, const Gemm g, const Sched& S, const Epi& E) {
    const int tid = threadIdx.x, wid = __builtin_amdgcn_readfirstlane(tid >> 6), lane = tid & 63, wr = wid >> 2, wc = wid & 3, fr = lane & 15, fq = lane >> 4;
    const int K = g.K, nt = K / BK;
    unsigned voffA[2], voffB[2];
#pragma unroll
    for (int i = 0; i < 2; ++i) { int R, C; stage_rc(tid * 16 + i * 8192, R, C); const int Rb = Epi::PERM ? ((R & ~31) + perm32(R & 31)) : R;
        voffA[i] = (unsigned)(R * K + C) * 2u; voffB[i] = (unsigned)(Rb * K + C) * 2u; }
    const size_t kstep = (size_t)(BK * 2);
    const size_t hstep = (size_t)HALF * K * 2;
    const size_t tstep = 2 * hstep;
    const unsigned ldsw = (unsigned)wid * 1024u;
    const int aoff = lds_byte(wr * 64 + fr, fq * 8), boff = lds_byte(wc * 32 + fr, fq * 8);
#define PG8_SA(b, h) (((b) * 2 + (h)) * HTB)
#define PG8_SB(b, h) ((4 + (b) * 2 + (h)) * HTB)
#define PG8_STAGE(bufoff, gbase, voff) do { _Pragma("unroll") for (int _i = 0; _i < 2; ++_i) \
        __builtin_amdgcn_global_load_lds((const unsigned*)((const char*)(gbase) + (voff)[_i]), (PG8_LAS unsigned*)(lds + (bufoff) + ldsw + _i * 8192), 16, 0, 0); } while (0)
#define PG8_LDA(dst, b, h) do { _Pragma("unroll") for (int m = 0; m < 4; ++m) _Pragma("unroll") for (int k = 0; k < 2; ++k) dst[m][k] = *(const PG8_LAS bf16x8*)(lds + PG8_SA(b, h) + aoff + m * 2048 + k * 1024); } while (0)
#define PG8_LDB(dst, b, h) do { _Pragma("unroll") for (int n = 0; n < 2; ++n) _Pragma("unroll") for (int k = 0; k < 2; ++k) dst[n][k] = *(const PG8_LAS bf16x8*)(lds + PG8_SB(b, h) + boff + n * 2048 + k * 1024); } while (0)
#define PG8_MMA(ai, bj, At, Bt) do { __builtin_amdgcn_s_setprio(1); _Pragma("unroll") for (int m = 0; m < 4; ++m) _Pragma("unroll") for (int n = 0; n < 2; ++n) _Pragma("unroll") for (int k = 0; k < 2; ++k) \
        acc[ai][bj][m][n] = __builtin_amdgcn_mfma_f32_16x16x32_bf16(Bt[n][k], At[m][k], acc[ai][bj][m][n], 0, 0, 0); __builtin_amdgcn_s_setprio(0); } while (0)
#define PG8_WAIT_V(n) asm volatile("s_waitcnt vmcnt(" #n ")" ::: "memory")
#define PG8_WAIT_L(n) asm volatile("s_waitcnt lgkmcnt(" #n ")" ::: "memory")
#define PG8_BAR __builtin_amdgcn_s_barrier()
#define PG8_SCHED __builtin_amdgcn_sched_barrier(0)
    Unit cur, nxt; int ui = 0;
    if (!S.next(0, cur)) return;
    f32x4 acc[2][2][4][2];
#pragma unroll
    for (int a = 0; a < 2; ++a)
#pragma unroll
        for (int b = 0; b < 2; ++b)
#pragma unroll
            for (int m = 0; m < 4; ++m)
#pragma unroll
                for (int n = 0; n < 2; ++n) acc[a][b][m][n] = (f32x4){0.f, 0.f, 0.f, 0.f};
    bf16x8 At[4][2], B0[2][2], B1[2][2];
    const char* cA = (const char*)g.A + (size_t)cur.pm * tstep; const char* cB = (const char*)g.Bt + (size_t)cur.pn * tstep;
    S.a_ready(cur);
    if constexpr (SP2) {
        PG8_STAGE(PG8_SB(0, 0), cB, voffB); PG8_STAGE(PG8_SB(0, 1), cB + hstep, voffB); PG8_STAGE(PG8_SA(0, 0), cA, voffA); PG8_STAGE(PG8_SA(0, 1), cA + hstep, voffA);
        if (wr == 1) PG8_BAR;
        PG8_WAIT_V(2); PG8_BAR;
        PG8_STAGE(PG8_SB(1, 0), cB + kstep, voffB); PG8_STAGE(PG8_SA(1, 0), cA + kstep, voffA); PG8_STAGE(PG8_SB(1, 1), cB + hstep + kstep, voffB);
        PG8_WAIT_V(6); PG8_BAR;
    } else {
        PG8_STAGE(PG8_SB(0, 0), cB, voffB); PG8_STAGE(PG8_SA(0, 0), cA, voffA); PG8_STAGE(PG8_SB(0, 1), cB + hstep, voffB); PG8_STAGE(PG8_SA(0, 1), cA + hstep, voffA);
        if (wr == 1) PG8_BAR;
        PG8_WAIT_V(4); PG8_BAR;
        PG8_STAGE(PG8_SB(1, 0), cB + kstep, voffB); PG8_STAGE(PG8_SA(1, 0), cA + kstep, voffA); PG8_STAGE(PG8_SB(1, 1), cB + hstep + kstep, voffB);
        PG8_WAIT_V(6); PG8_BAR;
    }
    for (;;) {
        const bool has_next = S.next(ui + 1, nxt);
        const char* nA = has_next ? (const char*)g.A + (size_t)nxt.pm * tstep : cA; const char* nB = has_next ? (const char*)g.Bt + (size_t)nxt.pn * tstep : cB;
        for (int t = 0; t < nt; t += 2) {
            const bool last = (t == nt - 2);
            const char* a1 = cA + (size_t)(t + 1) * kstep;
            const char* a2 = last ? nA : cA + (size_t)(t + 2) * kstep; const char* b2 = last ? nB : cB + (size_t)(t + 2) * kstep;
            const char* a3 = a2 + kstep; const char* b3 = b2 + kstep;
            if (last && has_next) S.a_ready(nxt);
            if constexpr (SP2) {
            PG8_LDB(B0, 0, 0); PG8_LDB(B1, 0, 1); PG8_SCHED; PG8_LDA(At, 0, 0); PG8_STAGE(PG8_SA(1, 1), a1 + hstep, voffA);
            PG8_WAIT_V(8); PG8_WAIT_L(0); PG8_BAR; PG8_MMA(0, 0, At, B0); PG8_MMA(0, 1, At, B1); PG8_BAR; PG8_SCHED;
            PG8_LDA(At, 0, 1); PG8_STAGE(PG8_SB(0, 0), b2, voffB); PG8_STAGE(PG8_SB(0, 1), b2 + hstep, voffB); PG8_STAGE(PG8_SA(0, 0), a2, voffA);
            PG8_WAIT_V(8); PG8_WAIT_L(0); PG8_BAR; PG8_MMA(1, 0, At, B0); PG8_MMA(1, 1, At, B1); PG8_BAR; PG8_SCHED;
            PG8_LDB(B0, 1, 0); PG8_LDB(B1, 1, 1); PG8_SCHED; PG8_LDA(At, 1, 0); PG8_STAGE(PG8_SA(0, 1), a2 + hstep, voffA);
            PG8_WAIT_V(8); PG8_WAIT_L(0); PG8_BAR; PG8_MMA(0, 0, At, B0); PG8_MMA(0, 1, At, B1); PG8_BAR; PG8_SCHED;
            PG8_LDA(At, 1, 1); PG8_STAGE(PG8_SB(1, 0), b3, voffB); PG8_STAGE(PG8_SB(1, 1), b3 + hstep, voffB); PG8_STAGE(PG8_SA(1, 0), a3, voffA);
            PG8_WAIT_V(8); PG8_WAIT_L(0); PG8_BAR; PG8_MMA(1, 0, At, B0); PG8_MMA(1, 1, At, B1); PG8_BAR; PG8_SCHED;
            } else {
            PG8_LDB(B0, 0, 0); PG8_SCHED; PG8_LDA(At, 0, 0); PG8_STAGE(PG8_SA(1, 1), a1 + hstep, voffA);
            PG8_WAIT_L(8); PG8_BAR; PG8_WAIT_L(0); PG8_MMA(0, 0, At, B0); PG8_BAR; PG8_SCHED;
            PG8_LDB(B1, 0, 1); PG8_STAGE(PG8_SB(0, 0), b2, voffB);
            PG8_BAR; PG8_WAIT_L(0); PG8_MMA(0, 1, At, B1); PG8_BAR;
            PG8_LDA(At, 0, 1); PG8_STAGE(PG8_SA(0, 0), a2, voffA);
            PG8_BAR; PG8_WAIT_L(0); PG8_MMA(1, 0, At, B0); PG8_BAR; PG8_SCHED;
            PG8_STAGE(PG8_SB(0, 1), b2 + hstep, voffB);
            PG8_WAIT_V(6); PG8_BAR; PG8_MMA(1, 1, At, B1); PG8_BAR;
            PG8_LDB(B0, 1, 0); PG8_SCHED; PG8_LDA(At, 1, 0); PG8_STAGE(PG8_SA(0, 1), a2 + hstep, voffA);
            PG8_WAIT_L(8); PG8_BAR; PG8_WAIT_L(0); PG8_MMA(0, 0, At, B0); PG8_BAR; PG8_SCHED;
            PG8_LDB(B1, 1, 1); PG8_STAGE(PG8_SB(1, 0), b3, voffB);
            PG8_BAR; PG8_WAIT_L(0); PG8_MMA(0, 1, At, B1); PG8_BAR;
            PG8_LDA(At, 1, 1); PG8_STAGE(PG8_SA(1, 0), a3, voffA);
            PG8_BAR; PG8_WAIT_L(0); PG8_MMA(1, 0, At, B0); PG8_BAR; PG8_SCHED;
            PG8_STAGE(PG8_SB(1, 1), b3 + hstep, voffB);
            PG8_WAIT_V(6); PG8_BAR; PG8_MMA(1, 1, At, B1); PG8_BAR;
            }
        }
        if constexpr (ALIGN_EPI) { if (wr == 0) PG8_BAR; }
        if constexpr (!Epi::AFTER_DRAIN) { E(acc, cur, wr, wc, fr, fq); S.done(cur); }
        if (!has_next) break;
#pragma unroll
        for (int a = 0; a < 2; ++a)
#pragma unroll
            for (int b = 0; b < 2; ++b)
#pragma unroll
                for (int m = 0; m < 4; ++m)
#pragma unroll
                    for (int n = 0; n < 2; ++n) acc[a][b][m][n] = (f32x4){0.f, 0.f, 0.f, 0.f};
        cur = nxt; cA = nA; cB = nB; ++ui;
        if constexpr (ALIGN_EPI) { if (wr == 1) PG8_BAR; }
    }
    PG8_WAIT_V(0);
    if constexpr (!ALIGN_EPI) { if (wr == 0) PG8_BAR; }
    PG8_BAR;
    if constexpr (Epi::AFTER_DRAIN) { E.fused(acc, cur, wr, wc, fr, fq, lds, wid, lane); S.done(cur); }
#undef PG8_SA
#undef PG8_SB
#undef PG8_STAGE
#undef PG8_LDA
#undef PG8_LDB
#undef PG8_MMA
#undef PG8_WAIT_V
#undef PG8_WAIT_L
#undef PG8_BAR
#undef PG8_SCHED
}
}

#ifndef PG8_SP2
#define PG8_SP2 true
#endif
#ifndef PG8_ALIGN
#define PG8_ALIGN true
#endif
#define GAS __attribute__((address_space(1)))
#define LAS __attribute__((address_space(3)))
typedef unsigned short bf16;
typedef unsigned v4u __attribute__((ext_vector_type(4)));
typedef float f32x4 __attribute__((ext_vector_type(4)));
typedef short bf16x8 __attribute__((ext_vector_type(8)));
typedef GAS unsigned gu32;
typedef GAS unsigned long long gu64;
#define RLX_AGENT __ATOMIC_RELAXED, __HIP_MEMORY_SCOPE_AGENT
#define LDS_WAIT() asm volatile("s_waitcnt lgkmcnt(0)" ::: "memory")
#define VM_WAIT() asm volatile("s_waitcnt vmcnt(0)" ::: "memory")
__device__ __forceinline__ unsigned long long rt() { return __builtin_amdgcn_s_memrealtime(); }
__device__ __forceinline__ unsigned f2bf(float f) { unsigned u = __builtin_bit_cast(unsigned, f); return (u + 0x7fffu + ((u >> 16) & 1u)) >> 16; }
__device__ __forceinline__ unsigned pk2(float lo, float hi) { return f2bf(lo) | (f2bf(hi) << 16); }
#define XB_TMO      128
#define XB_XCNT(j)  (256  + 64 * (j))
#define XB_XSUB(j)  (1280 + 64 * (j))
#define XB_XGEN(j)  (2304 + 64 * (j))
#define XB_TOP      3328
#define XB_TOPGEN   3392
#define XCD_BAR_WORDS 3456
#define XB_SPIN_CAP (1u << 18)

__device__ __forceinline__ unsigned xb_ld(unsigned* p)              { return __hip_atomic_load(p, __ATOMIC_RELAXED, __HIP_MEMORY_SCOPE_AGENT); }
__device__ __forceinline__ unsigned xb_add(unsigned* p, unsigned v) { return __hip_atomic_fetch_add(p, v, __ATOMIC_RELAXED, __HIP_MEMORY_SCOPE_AGENT); }
__device__ __forceinline__ unsigned xb_xcc_id() { return (unsigned)__builtin_amdgcn_s_getreg((3 << 11) | 20) & 0xFu; }
#define XB_SPIN(cond, bar) do { unsigned _sp = 0; while (cond) { __builtin_amdgcn_s_sleep(1); \
    if ((++_sp & 255u) == 0u) { if (xb_ld(&(bar)[XB_TMO])) break; if (_sp > XB_SPIN_CAP) { atomicAdd(&(bar)[XB_TMO], 1u); break; } } } } while (0)

struct XcdBarrier {
    unsigned* bar; unsigned x;
    volatile LAS unsigned* st;
};

__device__ __forceinline__ XcdBarrier xcd_barrier_post(unsigned* bar, volatile LAS unsigned* st) {
    XcdBarrier b; b.bar = bar; b.x = xb_xcc_id(); b.st = st;
    if (threadIdx.x == 0) (void)xb_add(&bar[XB_XCNT(b.x)], 1u);
    return b;
}
__device__ __forceinline__ void xcd_barrier_complete(unsigned* bar, unsigned x, unsigned& nloc, unsigned& nx) {
    const unsigned G = gridDim.x * gridDim.y * gridDim.z;
    unsigned sum, cnt, mine, sp = 0u;
    for (;;) {
        sum = 0u; cnt = 0u; mine = 0u;
#pragma unroll
        for (unsigned j = 0; j < 16; ++j) { const unsigned c = xb_ld(&bar[XB_XCNT(j)]); sum += c; cnt += (c > 0u) ? 1u : 0u; mine = (j == x) ? c : mine; }
        if (sum == G) break;
        __builtin_amdgcn_s_sleep(1);
        if ((++sp & 255u) == 0u) { if (xb_ld(&bar[XB_TMO])) break; if (sp > XB_SPIN_CAP) { atomicAdd(&bar[XB_TMO], 1u); break; } }
    }
    nloc = mine > 0u ? mine : 1u; nx = cnt > 0u ? cnt : 1u;
}

__device__ __forceinline__ void xcd_barrier(const XcdBarrier& b) {
    asm volatile("s_waitcnt vmcnt(0)" ::: "memory");
    __syncthreads();
    if (threadIdx.x == 0) {
        unsigned* bar = b.bar;
        __builtin_amdgcn_s_waitcnt(0);
        unsigned nloc = b.st[0], nx = b.st[1];
        if (nloc == 0u) { xcd_barrier_complete(bar, b.x, nloc, nx); b.st[0] = nloc; b.st[1] = nx; }
        const unsigned old = xb_add(&bar[XB_XSUB(b.x)], 1u);
        const unsigned gen = old / nloc;
        if (old + 1u == (gen + 1u) * nloc) {
            __builtin_amdgcn_fence(__ATOMIC_RELEASE, "agent");
            asm volatile("s_waitcnt vmcnt(0)" ::: "memory");
            const unsigned og = xb_add(&bar[XB_TOP], 1u);
            const unsigned tg = og / nx;
            if (og + 1u == (tg + 1u) * nx) xb_add(&bar[XB_TOPGEN], 1u);
            else XB_SPIN(xb_ld(&bar[XB_TOPGEN]) == tg, bar);
            __builtin_amdgcn_fence(__ATOMIC_ACQUIRE, "agent");
            xb_add(&bar[XB_XGEN(b.x)], 1u);
            asm volatile("s_waitcnt vmcnt(0)" ::: "memory");
        } else {
            XB_SPIN(xb_ld(&bar[XB_XGEN(b.x)]) == gen, bar);
            __builtin_amdgcn_fence(__ATOMIC_ACQUIRE, "agent");
            asm volatile("s_waitcnt vmcnt(0)" ::: "memory");
        }
    }
    __syncthreads();
}
constexpr int NWAVES = 8, NTHR = 512;
constexpr int D = 1024, MP = 16384, MS = 128, MREAL = MP + MS, MT = 16640, NZ = 3584, DFF = 2688, NU = 5376;
constexpr int TP = 4096, BP = 4, BS = 32, TS = 4, PAST = 16384, NPAGES = 128, WPOS0_S = 15872;
constexpr float ALPHA = 1.189207115002721f, LN_EPS = 1e-5f;
constexpr int ZC_QK = 0, ZC_V = 1024, ZC_O = 1536, ZC_NQ = 2048, ZC_KV = 2560, ZC_WIN = 3072, ZC_G = 3328;
enum { I_XP = 0, I_XS, I_CKV, I_CWIN, I_SC, I_SN, I_SM, I_SMC, I_SFC, I_PT, I_WIN, I_BIN, I_MCW, I_MCB, I_MNW, I_POOL, I_RB, I_WOUT, I_LN1W, I_LN1B, I_WUP, I_BUP, I_FCW, I_FCB, I_WDN, I_BDN, I_LN2W, I_LN2B, N_IN };
constexpr size_t O_Y_P = 0, O_Y_S = O_Y_P + (size_t)MP * D, O_KV_P = O_Y_S + (size_t)MS * D, O_KV_S = O_KV_P + (size_t)MP * 512, O_WIN_P = O_KV_S + (size_t)MS * 512,
    O_WIN_S = O_WIN_P + (size_t)BP * 512 * 256, O_C_P = O_WIN_S + (size_t)BS * 512 * 256, O_C_S = O_C_P + (size_t)BP * 8 * 4096, O_N_P = O_C_S + (size_t)BS * 8 * 4096,
    O_N_S = O_N_P + BP * 8 * 64, O_M_P = O_N_S + BS * 8 * 64, O_M_S = O_M_P + BP * 8, O_MC_P = O_M_S + BS * 8, O_MC_S = O_MC_P + BP * 3 * 1024, O_FC_P = O_MC_S + BS * 3 * 1024,
    O_FC_S = O_FC_P + (size_t)BP * 2 * NU, O_END = O_FC_S + (size_t)BS * 2 * NU;
static_assert(O_END == 31777056, "output size");
constexpr size_t MiB = 1u << 20;
constexpr size_t WS_CTL = 0, CTL_ZERO_BYTES = 1 * MiB;
constexpr size_t WS_WIN_T = 2 * MiB, WS_WOUT_T = 10 * MiB, WS_WUP_T = 12 * MiB, WS_WDN_T = 24 * MiB, WS_ZB = 30 * MiB, WS_XB = 32 * MiB, WS_Z = 66 * MiB, WS_G = 180 * MiB,
    WS_QC = 186 * MiB, WS_H = 220 * MiB, WS_MIX = 254 * MiB, WS_R = 288 * MiB, WS_X1 = 354 * MiB, WS_X1B = 420 * MiB, WS_U = 454 * MiB, WS_FF = 626 * MiB, WS_KCS = 712 * MiB,
    WS_KCP = 728 * MiB, WS_END = 736 * MiB;
constexpr int CW_BAR = 4096;

struct Args { const float* in[N_IN]; float* out; unsigned char* ws; };

__device__ __forceinline__ float bf2f(bf16 v) { return __builtin_bit_cast(float, (unsigned)v << 16); }
__device__ __forceinline__ float sigmoidf_(float x) { return 1.f / (1.f + __expf(-x)); }
__device__ __forceinline__ float logsigmoidf_(float x) { return fminf(x, 0.f) - log1pf(__expf(-fabsf(x))); }
__device__ __forceinline__ float gelu_tanh(float x) { const float u = 0.7978845608028654f * (x + 0.044715f * x * x * x); return 0.5f * x * (1.f + tanhf(u)); }
__device__ __forceinline__ float wave_sum(float v) {
#pragma unroll
    for (int o = 1; o < 64; o <<= 1) v += __shfl_xor(v, o);
    return v;
}
__device__ __forceinline__ float wave_max(float v) {
#pragma unroll
    for (int o = 1; o < 64; o <<= 1) v = fmaxf(v, __shfl_xor(v, o));
    return v;
}
__device__ __forceinline__ int zcol_old(int c) {
    if (c < 2048) return c;
    if (c < 3328) return c + 16;
    if (c < 3344) return c - 1280;
    if (c < 3368) return c;
    return -1;
}
__device__ __forceinline__ int t5_bucket(int n) {
    if (n < 16) return n;
    const int v = 16 + (int)(logf((float)n * 0.0625f) / 2.0794415416798357f * 16.f);
    return v < 31 ? v : 31;
}

template <bool ZMAP> __device__ __forceinline__ void p0_transpose_item(const float* W, int K, int Nold, int N, bf16* WT, LAS float* scr, int item, int lane) {
    const int nblk = N / 32, kb = item / nblk, nb = item % nblk, k0 = 64 * kb, n0 = 32 * nb;
    const int ncol = n0 + (lane & 31); const int oc = ZMAP ? zcol_old(ncol) : ncol;
#pragma unroll 8
    for (int i = 0; i < 32; ++i) { const int kk = 2 * i + (lane >> 5); scr[kk * 33 + (lane & 31)] = (oc >= 0) ? W[(size_t)(k0 + kk) * Nold + oc] : 0.f; }
    LDS_WAIT(); asm volatile("" ::: "memory");
    const int c = lane & 7;
#pragma unroll
    for (int j = 0; j < 4; ++j) { const int n = (lane >> 3) + 8 * j; const LAS float* s = scr + (8 * c) * 33 + n;
        v4u o; o.x = pk2(s[0 * 33], s[1 * 33]); o.y = pk2(s[2 * 33], s[3 * 33]); o.z = pk2(s[4 * 33], s[5 * 33]); o.w = pk2(s[6 * 33], s[7 * 33]);
        *(GAS v4u*)(WT + (size_t)(n0 + n) * K + k0 + 8 * c) = o; }
    LDS_WAIT(); asm volatile("" ::: "memory");
}

__device__ __forceinline__ void p0_prologue(const Args& a, LAS unsigned char* lds, int gw, int NGW, int gt, int NGT, int wave, int lane) {
    unsigned char* ws = a.ws;
    LAS float* scr = (LAS float*)(lds + wave * 16384);
    constexpr int I_A = (D / 64) * (NZ / 32), I_B = (D / 64) * (D / 32), I_C = (D / 64) * (NU / 32), I_D = (DFF / 64) * (D / 32);
    for (int it = gw; it < I_A + I_B + I_C + I_D; it += NGW) {
        int r = it;
        if (r < I_A) { p0_transpose_item<true>(a.in[I_WIN], D, 3368, NZ, (bf16*)(ws + WS_WIN_T), scr, r, lane); continue; } r -= I_A;
        if (r < I_B) { p0_transpose_item<false>(a.in[I_WOUT], D, D, D, (bf16*)(ws + WS_WOUT_T), scr, r, lane); continue; } r -= I_B;
        if (r < I_C) { p0_transpose_item<false>(a.in[I_WUP], D, NU, NU, (bf16*)(ws + WS_WUP_T), scr, r, lane); continue; } r -= I_C;
        p0_transpose_item<false>(a.in[I_WDN], DFF, D, D, (bf16*)(ws + WS_WDN_T), scr, r, lane);
    }
    { float* zb = (float*)(ws + WS_ZB); const float* bin = a.in[I_BIN]; for (int c = gt; c < NZ; c += NGT) { const int oc = zcol_old(c); zb[c] = oc >= 0 ? bin[oc] : 0.f; } }
    { bf16* xb = (bf16*)(ws + WS_XB);
      for (int m = gw; m < MT; m += NGW) {
          GAS unsigned long long* o8 = (GAS unsigned long long*)(xb + (size_t)m * D) + lane;
          if (m < MREAL) { const float* xr = m < MP ? a.in[I_XP] + (size_t)m * D : a.in[I_XS] + (size_t)(m - MP) * D; const GAS f32x4* x4 = (const GAS f32x4*)xr + lane;
#pragma unroll
              for (int j = 0; j < 4; ++j) { const f32x4 v = x4[64 * j]; o8[64 * j] = (unsigned long long)pk2(v.x, v.y) | ((unsigned long long)pk2(v.z, v.w) << 32); } }
          else {
#pragma unroll
              for (int j = 0; j < 4; ++j) o8[64 * j] = 0ull; } } }
    { float* kcs = (float*)(ws + WS_KCS); const float* cache = a.in[I_CKV]; const int* pt = (const int*)a.in[I_PT]; const float* pw = a.in[I_POOL];
      const int e = lane >> 5, g = (lane >> 4) & 1;
      for (int u = gw; u < BS * 512; u += NGW) { const int b = u >> 9, c = u & 511; const int page = pt[b * NPAGES + (c >> 2)];
          const float* src = cache + ((size_t)page * 128 + (c & 3) * 32) * 512 + lane * 4; f32x4 acc = {0.f, 0.f, 0.f, 0.f};
#pragma unroll 8
          for (int j = 0; j < 32; ++j) { const f32x4 v = *(const GAS f32x4*)(src + (size_t)j * 512); const float w = pw[(e * 32 + j) * 2 + g]; acc += v * w; }
          *(GAS f32x4*)(kcs + (size_t)u * 256 + lane * 4) = acc; } }
    { const float* cw = a.in[I_CWIN]; float* wo = a.out + O_WIN_S;
      for (int i = gt; i < BS * 508 * 64; i += NGT) { const int b = i / (508 * 64), r = i % (508 * 64);
          *(GAS f32x4*)(wo + (size_t)b * 512 * 256 + (size_t)r * 4) = *(const GAS f32x4*)(cw + (size_t)b * 512 * 256 + 4 * 256 + (size_t)r * 4); } }
}

__device__ __forceinline__ void z_store1(const Args& a, int row, int col, float v) {
    ((bf16*)(a.ws + WS_Z))[(size_t)row * NZ + col] = (bf16)f2bf(v);
    if (row >= MREAL) return;
    const bool samp = row >= MP; const int b = samp ? (row - MP) >> 2 : row >> 12, t = samp ? (row - MP) & 3 : row & 4095;
    if (col < 1024) { if (!samp) { if (t >= TP - 3) a.out[O_MC_P + (size_t)(b * 3 + t - (TP - 3)) * 1024 + col] = v; } else if (t >= 1) a.out[O_MC_S + (size_t)(b * 3 + t - 1) * 1024 + col] = v; }
    else if (col >= ZC_KV && col < ZC_WIN) { const int c2 = col - ZC_KV; if (!samp) a.out[O_KV_P + (size_t)row * 512 + c2] = v; else a.out[O_KV_S + (size_t)(row - MP) * 512 + c2] = v; }
    else if (col >= ZC_WIN && col < ZC_G) { const int c2 = col - ZC_WIN; if (!samp) { if (t >= TP - 512) a.out[O_WIN_P + ((size_t)b * 512 + t - (TP - 512)) * 256 + c2] = v; } else a.out[O_WIN_S + ((size_t)b * 512 + 508 + t) * 256 + c2] = v; }
    else if (col >= ZC_G && col < ZC_G + 64) ((float*)(a.ws + WS_G))[(size_t)row * 64 + col - ZC_G] = v;
}
__device__ __forceinline__ void u_store1(const Args& a, int row, int col, float v) {
    ((bf16*)(a.ws + WS_U))[(size_t)row * NU + col] = (bf16)f2bf(v);
    if (row >= MREAL) return;
    const bool samp = row >= MP; const int b = samp ? (row - MP) >> 2 : row >> 12, t = samp ? (row - MP) & 3 : row & 4095;
    if (!samp) { if (t >= TP - 2) a.out[O_FC_P + (size_t)(b * 2 + t - (TP - 2)) * NU + col] = v; } else if (t >= 2) a.out[O_FC_S + (size_t)(b * 2 + t - 2) * NU + col] = v;
}

template <class F> __device__ __forceinline__ void naive_gemm(const bf16* A, const bf16* Bt, int M, int N, int K, int gw, int NGW, int lane, const F& f) {
    const int nct = N / 8, total = (M / 8) * nct;
    for (int u = gw; u < total; u += NGW) {
        const int r = (u / nct) * 8 + (lane >> 3), c = (u % nct) * 8 + (lane & 7);
        const GAS v4u* ap = (const GAS v4u*)(A + (size_t)r * K); const GAS v4u* bp = (const GAS v4u*)(Bt + (size_t)c * K);
        float acc = 0.f;
        for (int k = 0; k < K / 8; ++k) { const v4u x = ap[k], y = bp[k];
            acc += __builtin_bit_cast(float, x.x << 16) * __builtin_bit_cast(float, y.x << 16) + __builtin_bit_cast(float, x.x & 0xffff0000u) * __builtin_bit_cast(float, y.x & 0xffff0000u);
            acc += __builtin_bit_cast(float, x.y << 16) * __builtin_bit_cast(float, y.y << 16) + __builtin_bit_cast(float, x.y & 0xffff0000u) * __builtin_bit_cast(float, y.y & 0xffff0000u);
            acc += __builtin_bit_cast(float, x.z << 16) * __builtin_bit_cast(float, y.z << 16) + __builtin_bit_cast(float, x.z & 0xffff0000u) * __builtin_bit_cast(float, y.z & 0xffff0000u);
            acc += __builtin_bit_cast(float, x.w << 16) * __builtin_bit_cast(float, y.w << 16) + __builtin_bit_cast(float, x.w & 0xffff0000u) * __builtin_bit_cast(float, y.w & 0xffff0000u); }
        f(r, c, acc);
    }
}

__device__ __forceinline__ void p2_conv_pool(const Args& a, int gw, int NGW, int gt, int NGT, int lane) {
    const bf16* Z = (const bf16*)(a.ws + WS_Z); bf16* QC = (bf16*)(a.ws + WS_QC);
    const float* cw = a.in[I_MCW]; const float* cb = a.in[I_MCB]; const float* smc = a.in[I_SMC];
    for (int i = gt; i < MREAL * 1024; i += NGT) { const int row = i >> 10, c = i & 1023;
        const bool samp = row >= MP; const int b = samp ? (row - MP) >> 2 : row >> 12, t = samp ? (row - MP) & 3 : row & 4095;
        float acc = cb[c];
#pragma unroll
        for (int j = 0; j < 4; ++j) { const int tt = t - 3 + j; float v;
            if (tt >= 0) v = bf2f(Z[(size_t)(row - 3 + j) * NZ + c]); else v = samp ? smc[(size_t)(b * 3 + 3 + tt) * 1024 + c] : 0.f;
            acc += cw[j * 1024 + c] * v; }
        float s = acc * sigmoidf_(acc); if (c >= 512) s *= 0.125f;
        QC[(size_t)row * 1024 + c] = (bf16)f2bf(s); }
    { float* kcp = (float*)(a.ws + WS_KCP); const float* kv = a.out + O_KV_P; const float* pw = a.in[I_POOL]; const int e = lane >> 5, g = (lane >> 4) & 1;
      for (int u = gw; u < BP * 128; u += NGW) { const int b = u >> 7, c = u & 127; const float* src = kv + ((size_t)b * TP + c * 32) * 512 + lane * 4; f32x4 acc = {0.f, 0.f, 0.f, 0.f};
#pragma unroll 8
          for (int j = 0; j < 32; ++j) { const f32x4 v = *(const GAS f32x4*)(src + (size_t)j * 512); const float w = pw[(e * 32 + j) * 2 + g]; acc += v * w; }
          *(GAS f32x4*)(kcp + (size_t)u * 256 + lane * 4) = acc; } }
}

__device__ __forceinline__ void mlstm_chain(const Args& a, bool samp, int b, int h, int tid) {
    const bf16* Z = (const bf16*)(a.ws + WS_Z); const bf16* QC = (const bf16*)(a.ws + WS_QC); const float* G = (const float*)(a.ws + WS_G); float* H = (float*)(a.ws + WS_H);
    const int e = tid >> 3, dq = tid & 7; const int T = samp ? TS : TP; const int rowbase = samp ? MP + b * TS : b * TP;
    float C[8], n[8]; float m;
#pragma unroll
    for (int i = 0; i < 8; ++i) { C[i] = samp ? a.in[I_SC][((size_t)(b * 8 + h) * 64 + e) * 64 + dq * 8 + i] : 0.f; n[i] = samp ? a.in[I_SN][(size_t)(b * 8 + h) * 64 + dq * 8 + i] : 0.f; }
    m = samp ? a.in[I_SM][b * 8 + h] : 0.f;
    for (int t = 0; t < T; ++t) { const size_t row = (size_t)rowbase + t;
        const v4u q8 = *(const GAS v4u*)(QC + row * 1024 + h * 64 + dq * 8), k8 = *(const GAS v4u*)(QC + row * 1024 + 512 + h * 64 + dq * 8);
        const float v = bf2f(Z[row * NZ + ZC_V + h * 64 + e]); const float ig = G[row * 64 + h], fg = G[row * 64 + 8 + h];
        float q[8], k[8];
        q[0] = __builtin_bit_cast(float, q8.x << 16); q[1] = __builtin_bit_cast(float, q8.x & 0xffff0000u); q[2] = __builtin_bit_cast(float, q8.y << 16); q[3] = __builtin_bit_cast(float, q8.y & 0xffff0000u);
        q[4] = __builtin_bit_cast(float, q8.z << 16); q[5] = __builtin_bit_cast(float, q8.z & 0xffff0000u); q[6] = __builtin_bit_cast(float, q8.w << 16); q[7] = __builtin_bit_cast(float, q8.w & 0xffff0000u);
        k[0] = __builtin_bit_cast(float, k8.x << 16); k[1] = __builtin_bit_cast(float, k8.x & 0xffff0000u); k[2] = __builtin_bit_cast(float, k8.y << 16); k[3] = __builtin_bit_cast(float, k8.y & 0xffff0000u);
        k[4] = __builtin_bit_cast(float, k8.z << 16); k[5] = __builtin_bit_cast(float, k8.z & 0xffff0000u); k[6] = __builtin_bit_cast(float, k8.w << 16); k[7] = __builtin_bit_cast(float, k8.w & 0xffff0000u);
        const float lf = logsigmoidf_(fg); const float mn = fmaxf(lf + m, ig); const float fs = __expf(lf + m - mn), is = __expf(ig - mn);
        float pn = 0.f, pd = 0.f;
#pragma unroll
        for (int i = 0; i < 8; ++i) { C[i] = fs * C[i] + is * v * k[i]; n[i] = fs * n[i] + is * k[i]; pn += C[i] * q[i]; pd += n[i] * q[i]; }
        pn += __shfl_xor(pn, 1); pn += __shfl_xor(pn, 2); pn += __shfl_xor(pn, 4);
        pd += __shfl_xor(pd, 1); pd += __shfl_xor(pd, 2); pd += __shfl_xor(pd, 4);
        const float den = fmaxf(fabsf(pd), __expf(-mn));
        if (dq == 0) H[row * 512 + h * 64 + e] = pn / den;
        m = mn; }
    float* co = a.out + (samp ? O_C_S : O_C_P) + ((size_t)(b * 8 + h) * 64 + e) * 64 + dq * 8;
#pragma unroll
    for (int i = 0; i < 8; ++i) co[i] = C[i];
    if (e == 0) { float* no = a.out + (samp ? O_N_S : O_N_P) + (size_t)(b * 8 + h) * 64 + dq * 8;
#pragma unroll
        for (int i = 0; i < 8; ++i) no[i] = n[i]; }
    if (tid == 0) a.out[(samp ? O_M_S : O_M_P) + b * 8 + h] = m;
}

constexpr int SCP = 1040;
struct NsaLds { LAS float *BT, *QS, *SC, *IMP, *RED, *OACC, *STAT; LAS int* LIST; };
__device__ __forceinline__ NsaLds nsa_lds(LAS unsigned char* lds) { NsaLds L; L.BT = (LAS float*)lds; L.QS = L.BT + 1024; L.SC = L.QS + 256; L.IMP = L.SC + 4 * SCP; L.LIST = (LAS int*)(L.IMP + 272); L.RED = (LAS float*)(L.LIST + 32); L.OACC = L.RED + 2048; L.STAT = L.OACC + 768; return L; }
__device__ __forceinline__ void nsa_softmax_stats(const NsaLds& L, int n, int wave, int lane) {
    if (wave < 4) { LAS float* s = L.SC + wave * SCP; float mx = -INFINITY;
        for (int i = lane; i < n; i += 64) mx = fmaxf(mx, s[i]);
        mx = wave_max(mx); if (!(mx > -INFINITY)) mx = 0.f;
        float sum = 0.f;
        for (int i = lane; i < n; i += 64) { const float ev = __expf(s[i] - mx); s[i] = ev; sum += ev; }
        sum = wave_sum(sum); if (lane == 0) L.STAT[wave] = 1.f / fmaxf(sum, 1e-30f); }
}
template <class VF> __device__ __forceinline__ void nsa_pv(const NsaLds& L, int n, int br, int tid, const VF& vf) {
    const int sl = tid >> 6, d = tid & 63; float a0 = 0.f, a1 = 0.f, a2 = 0.f, a3 = 0.f;
    for (int i = sl; i < n; i += 8) { const float p0 = L.SC[i], p1 = L.SC[SCP + i], p2 = L.SC[2 * SCP + i], p3 = L.SC[3 * SCP + i];
        if (p0 != 0.f || p1 != 0.f || p2 != 0.f || p3 != 0.f) { const float v = vf(i, d); a0 += p0 * v; a1 += p1 * v; a2 += p2 * v; a3 += p3 * v; } }
    L.RED[sl * 256 + d] = a0; L.RED[sl * 256 + 64 + d] = a1; L.RED[sl * 256 + 128 + d] = a2; L.RED[sl * 256 + 192 + d] = a3;
    __syncthreads();
    if (tid < 256) { float s = 0.f;
#pragma unroll
        for (int k = 0; k < 8; ++k) s += L.RED[k * 256 + tid];
        L.OACC[br * 256 + tid] = s * L.STAT[tid >> 6]; }
    __syncthreads();
}
__device__ __forceinline__ void dot64x4(const float* kr, const LAS float* q, float (&s)[4]) {
    s[0] = s[1] = s[2] = s[3] = 0.f;
#pragma unroll 4
    for (int i = 0; i < 16; ++i) { const f32x4 kv = *(const GAS f32x4*)(kr + 4 * i);
#pragma unroll
        for (int h = 0; h < 4; ++h) { const LAS float* qq = q + h * 64 + 4 * i; s[h] += kv.x * qq[0] + kv.y * qq[1] + kv.z * qq[2] + kv.w * qq[3]; } }
}
__device__ __forceinline__ void nsa_bias_table(const Args& a, const NsaLds& L, int tid) {
    for (int i = tid; i < 1024; i += NTHR) { const int hd = i >> 7, n = i & 127; L.BT[i] = a.in[I_RB][t5_bucket(n) * 8 + hd]; }
    __syncthreads();
}
__device__ __forceinline__ void nsa_unit(const Args& a, const NsaLds& L, bool samp, int b, int g, int tl, int tid, int wave, int lane) {
    const bf16* Z = (const bf16*)(a.ws + WS_Z); const float* G = (const float*)(a.ws + WS_G);
    const int t = samp ? PAST + tl : tl; const size_t row = samp ? (size_t)MP + b * TS + tl : (size_t)b * TP + tl;
    const float* kc = samp ? (const float*)(a.ws + WS_KCS) + (size_t)b * 512 * 256 : (const float*)(a.ws + WS_KCP) + (size_t)b * 128 * 256;
    const int* pt = (const int*)a.in[I_PT] + b * NPAGES;
    if (tid < 256) L.QS[tid] = bf2f(Z[row * NZ + ZC_NQ + g * 256 + tid]) * 0.125f;
    __syncthreads();
    const int ncv = samp ? 512 : ((t + 1) >> 5);
    for (int c = tid; c < ncv; c += NTHR) { const float* kr = kc + (size_t)c * 256 + g * 64; const int dist = t - 32 * c - 31; const int dn = dist < 127 ? dist : 127;
        float s4[4]; dot64x4(kr, L.QS, s4);
#pragma unroll
        for (int h = 0; h < 4; ++h) L.SC[h * SCP + c] = s4[h] + L.BT[(g * 4 + h) * 128 + dn]; }
    __syncthreads();
    nsa_softmax_stats(L, ncv, wave, lane);
    __syncthreads();
    const int cur = t >> 6;
    for (int j = tid; j < cur; j += NTHR) { float s = 0.f;
#pragma unroll
        for (int h = 0; h < 4; ++h) s += L.STAT[h] * L.SC[h * SCP + 2 * j] + L.STAT[h] * L.SC[h * SCP + 2 * j + 1];
        L.IMP[j] = s; }
    nsa_pv(L, ncv, 0, tid, [&](int i, int d) { return kc[(size_t)i * 256 + 128 + g * 64 + d]; });
    const int nsb = cur < 15 ? cur + 1 : 16;
    if (cur <= 15) { if (tid <= cur) L.LIST[tid] = tid; }
    else { if (tid == 0) L.LIST[0] = cur;
        for (int j = tid; j < cur; j += NTHR) { const float v = L.IMP[j]; int rank = 0;
            for (int k = 0; k < cur; ++k) { const float w = L.IMP[k]; rank += (w > v || (w == v && k < j)) ? 1 : 0; }
            if (rank < 15) L.LIST[1 + rank] = j; } }
    __syncthreads();
    const int nks = nsb * 64;
    auto sel_row = [&](int idx, bool& valid) -> const float* { const int blk = L.LIST[idx >> 6], pos = blk * 64 + (idx & 63); valid = pos <= t;
        if (!samp) return a.out + O_KV_P + ((size_t)b * TP + pos) * 512;
        if (pos >= PAST) return a.out + O_KV_S + (size_t)(b * TS + (valid ? pos - PAST : 0)) * 512;
        return a.in[I_CKV] + ((size_t)pt[pos >> 7] * 128 + (pos & 127)) * 512; };
    for (int idx = tid; idx < nks; idx += NTHR) { bool valid; const float* r = sel_row(idx, valid); const int pos = L.LIST[idx >> 6] * 64 + (idx & 63); const int dist = t - pos; const int dn = dist < 127 ? dist : 127;
        if (valid) { float s4[4]; dot64x4(r + 256 + g * 64, L.QS, s4);
#pragma unroll
            for (int h = 0; h < 4; ++h) L.SC[h * SCP + idx] = s4[h] + L.BT[(g * 4 + h) * 128 + dn]; }
        else {
#pragma unroll
            for (int h = 0; h < 4; ++h) L.SC[h * SCP + idx] = -INFINITY; } }
    __syncthreads();
    nsa_softmax_stats(L, nks, wave, lane);
    __syncthreads();
    nsa_pv(L, nks, 1, tid, [&](int i, int d) { bool valid; const float* r = sel_row(i, valid); return valid ? r[384 + g * 64 + d] : 0.f; });
    const int lo = (t - 512 > (samp ? WPOS0_S : 0)) ? t - 512 : (samp ? WPOS0_S : 0); const int nkw = t - lo + 1;
    for (int i = tid; i < nkw; i += NTHR) { const int pos = lo + i; const int dist = t - pos; const int dn = dist < 127 ? dist : 127; float s[4];
        if (!samp) { const bf16* kr = Z + ((size_t)b * TP + pos) * NZ + ZC_WIN + g * 64; s[0] = s[1] = s[2] = s[3] = 0.f;
#pragma unroll 2
            for (int d8 = 0; d8 < 8; ++d8) { const v4u kk = *(const GAS v4u*)(kr + d8 * 8); const unsigned w[4] = {kk.x, kk.y, kk.z, kk.w};
#pragma unroll
                for (int p = 0; p < 4; ++p) { const float k0 = __builtin_bit_cast(float, w[p] << 16), k1 = __builtin_bit_cast(float, w[p] & 0xffff0000u);
#pragma unroll
                    for (int h = 0; h < 4; ++h) s[h] += k0 * L.QS[h * 64 + d8 * 8 + 2 * p] + k1 * L.QS[h * 64 + d8 * 8 + 2 * p + 1]; } } }
        else { const float* kr = pos < PAST ? a.in[I_CWIN] + ((size_t)(b * 512 + pos - WPOS0_S) * 2) * 128 + g * 64 : a.out + O_WIN_S + ((size_t)b * 512 + 508 + pos - PAST) * 256 + g * 64;
            dot64x4(kr, L.QS, s); }
#pragma unroll
        for (int h = 0; h < 4; ++h) L.SC[h * SCP + i] = s[h] + L.BT[(g * 4 + h) * 128 + dn]; }
    __syncthreads();
    nsa_softmax_stats(L, nkw, wave, lane);
    __syncthreads();
    nsa_pv(L, nkw, 2, tid, [&](int i, int d) { const int pos = lo + i;
        if (!samp) return bf2f(Z[((size_t)b * TP + pos) * NZ + ZC_WIN + 128 + g * 64 + d]);
        return pos < PAST ? a.in[I_CWIN][((size_t)(b * 512 + pos - WPOS0_S) * 2 + 1) * 128 + g * 64 + d] : a.out[O_WIN_S + ((size_t)b * 512 + 508 + pos - PAST) * 256 + 128 + g * 64 + d]; });
    if (tid < 256) { const int hd = g * 4 + (tid >> 6); const float* gr = G + row * 64 + 16 + hd;
        const float v = sigmoidf_(gr[0]) * L.OACC[tid] + sigmoidf_(gr[8]) * L.OACC[256 + tid] + sigmoidf_(gr[16]) * L.OACC[512 + tid];
        ((bf16*)(a.ws + WS_MIX))[row * 1024 + 512 + g * 256 + tid] = (bf16)f2bf(v); }
    __syncthreads();
}

__device__ __forceinline__ void p4_headnorm(const Args& a, int gw, int NGW, int lane) {
    const bf16* Z = (const bf16*)(a.ws + WS_Z); const float* H = (const float*)(a.ws + WS_H); bf16* MIX = (bf16*)(a.ws + WS_MIX); const float* nw = a.in[I_MNW];
    for (int u = gw; u < MT * 8; u += NGW) { const int row = u >> 3, hd = u & 7;
        if (row >= MREAL) { MIX[(size_t)row * 1024 + hd * 64 + lane] = 0; MIX[(size_t)row * 1024 + 512 + hd * 64 + lane] = 0; continue; }
        const float hv = H[(size_t)row * 512 + hd * 64 + lane]; const float mu = wave_sum(hv) * (1.f / 64.f); const float dv = hv - mu; const float var = wave_sum(dv * dv) * (1.f / 64.f);
        const float hn = dv * (1.f / sqrtf(var + LN_EPS)) * nw[hd * 64 + lane]; const float o = bf2f(Z[(size_t)row * NZ + ZC_O + hd * 64 + lane]);
        MIX[(size_t)row * 1024 + hd * 64 + lane] = (bf16)f2bf(sigmoidf_(o) * hn); }
}
template <bool FIRST> __device__ __forceinline__ void p_layernorm(const Args& a, int gw, int NGW, int lane) {
    const float* R = (const float*)(a.ws + WS_R); const float* w = a.in[FIRST ? I_LN1W : I_LN2W]; const float* bb = a.in[FIRST ? I_LN1B : I_LN2B];
    for (int m = gw; m < (FIRST ? MT : MREAL); m += NGW) {
        if (FIRST && m >= MREAL) { GAS unsigned long long* o8 = (GAS unsigned long long*)((bf16*)(a.ws + WS_X1B) + (size_t)m * D) + lane; GAS f32x4* o4 = (GAS f32x4*)((float*)(a.ws + WS_X1) + (size_t)m * D) + lane;
#pragma unroll
            for (int j = 0; j < 4; ++j) { o8[64 * j] = 0ull; o4[64 * j] = (f32x4){0.f, 0.f, 0.f, 0.f}; }
            continue; }
        const GAS f32x4* xr = (const GAS f32x4*)(R + (size_t)m * D) + lane; f32x4 v[4]; float s = 0.f;
#pragma unroll
        for (int j = 0; j < 4; ++j) { v[j] = xr[64 * j]; s += (v[j].x + v[j].y) + (v[j].z + v[j].w); }
        const float mean = wave_sum(s) * (1.f / D); float s2 = 0.f;
#pragma unroll
        for (int j = 0; j < 4; ++j) { v[j] = v[j] - mean; s2 += (v[j].x * v[j].x + v[j].y * v[j].y) + (v[j].z * v[j].z + v[j].w * v[j].w); }
        const float rstd = 1.f / sqrtf(wave_sum(s2) * (1.f / D) + LN_EPS);
        float* orow = FIRST ? (float*)(a.ws + WS_X1) + (size_t)m * D : (m < MP ? a.out + O_Y_P + (size_t)m * D : a.out + O_Y_S + (size_t)(m - MP) * D);
#pragma unroll
        for (int j = 0; j < 4; ++j) { const f32x4 ww = *((const GAS f32x4*)w + lane + 64 * j), bv = *((const GAS f32x4*)bb + lane + 64 * j); const f32x4 o = v[j] * rstd * ww + bv;
            *((GAS f32x4*)orow + lane + 64 * j) = o;
            if (FIRST) *((GAS unsigned long long*)((bf16*)(a.ws + WS_X1B) + (size_t)m * D) + lane + 64 * j) = (unsigned long long)pk2(o.x, o.y) | ((unsigned long long)pk2(o.z, o.w) << 32); } }
}
__device__ __forceinline__ void p8_convgate(const Args& a, int gt, int NGT) {
    const bf16* U = (const bf16*)(a.ws + WS_U); bf16* FF = (bf16*)(a.ws + WS_FF); const float* cw = a.in[I_FCW]; const float* cb = a.in[I_FCB]; const float* sfc = a.in[I_SFC];
    for (size_t i = gt; i < (size_t)MT * DFF; i += NGT) { const int row = (int)(i / DFF), c = (int)(i % DFF);
        if (row >= MREAL) { FF[i] = 0; continue; }
        const bool samp = row >= MP; const int b = samp ? (row - MP) >> 2 : row >> 12, t = samp ? (row - MP) & 3 : row & 4095;
        float u2[2];
#pragma unroll
        for (int hh = 0; hh < 2; ++hh) { const int col = c + hh * DFF; float acc = cb[col];
#pragma unroll
            for (int j = 0; j < 3; ++j) { const int tt = t - 2 + j; float v;
                if (tt >= 0) v = bf2f(U[(size_t)(row - 2 + j) * NU + col]); else v = samp ? sfc[(size_t)(b * 2 + 2 + tt) * NU + col] : 0.f;
                acc += cw[j * NU + col] * v; }
            u2[hh] = acc; }
        FF[i] = (bf16)f2bf(gelu_tanh(u2[0]) * u2[1]); }
}

constexpr int LDS_BYTES = 147456, RING_BYTES = 131072, LDSCTL_OFF = RING_BYTES, MISC_OFF = LDSCTL_OFF + 320;
#ifndef NAIVE_GEMM
#define NAIVE_GEMM 1
#endif
__global__ void __launch_bounds__(NTHR, 2) fwd_kernel(Args a) {
    extern __shared__ __attribute__((aligned(16))) unsigned char lds_raw[];
    LAS unsigned char* lds = (LAS unsigned char*)lds_raw;
    volatile LAS unsigned* MISC = (volatile LAS unsigned*)(lds + MISC_OFF);
    const int tid = threadIdx.x, lane = tid & 63, wave = __builtin_amdgcn_readfirstlane(tid >> 6);
    const int G = gridDim.x, bx = blockIdx.x; const int vcu = (G % 8 == 0) ? (bx % 8) * (G / 8) + bx / 8 : bx;
    const int gw = vcu * NWAVES + wave, NGW = G * NWAVES, gt = vcu * NTHR + tid, NGT = G * NTHR;
    for (int u = tid; u < (LDS_BYTES - LDSCTL_OFF) / 4; u += NTHR) ((LAS unsigned*)(lds + LDSCTL_OFF))[u] = 0u;
    __syncthreads();
    XcdBarrier bar = xcd_barrier_post((unsigned*)(a.ws + WS_CTL) + CW_BAR, MISC + 8);
    unsigned char* ws = a.ws;

    p0_prologue(a, lds, gw, NGW, gt, NGT, wave, lane);
    xcd_barrier(bar);
    { const float* zb = (const float*)(ws + WS_ZB);
      naive_gemm((const bf16*)(ws + WS_XB), (const bf16*)(ws + WS_WIN_T), MT, NZ, D, gw, NGW, lane, [&](int r, int c, float acc) { z_store1(a, r, c, acc + zb[c]); }); }
    xcd_barrier(bar);
    p2_conv_pool(a, gw, NGW, gt, NGT, lane);
    xcd_barrier(bar);
    for (int u = bx; u < BP * 8 + BS * 8; u += G) { if (u < BP * 8) mlstm_chain(a, false, u >> 3, u & 7, tid); else mlstm_chain(a, true, (u - BP * 8) >> 3, (u - BP * 8) & 7, tid); }
    { const NsaLds L = nsa_lds(lds); nsa_bias_table(a, L, tid);
      for (int u = bx; u < MP * 2 + MS * 2; u += G) {
          if (u < MS * 2) { const int b = u >> 3, g = (u >> 2) & 1, tl = u & 3; nsa_unit(a, L, true, b, g, tl, tid, wave, lane); }
          else { const int v = u - MS * 2; const int b = v >> 13, g = (v >> 12) & 1, tl = v & 4095; nsa_unit(a, L, false, b, g, tl, tid, wave, lane); } } }
    xcd_barrier(bar);
    p4_headnorm(a, gw, NGW, lane);
    xcd_barrier(bar);
    { float* R = (float*)(ws + WS_R);
      naive_gemm((const bf16*)(ws + WS_MIX), (const bf16*)(ws + WS_WOUT_T), MT, D, D, gw, NGW, lane, [&](int r, int c, float acc) {
          const float xv = r < MP ? a.in[I_XP][(size_t)r * D + c] : (r < MREAL ? a.in[I_XS][(size_t)(r - MP) * D + c] : 0.f); R[(size_t)r * D + c] = ALPHA * xv + acc; }); }
    xcd_barrier(bar);
    p_layernorm<true>(a, gw, NGW, lane);
    xcd_barrier(bar);
    { const float* bu = a.in[I_BUP];
      naive_gemm((const bf16*)(ws + WS_X1B), (const bf16*)(ws + WS_WUP_T), MT, NU, D, gw, NGW, lane, [&](int r, int c, float acc) { u_store1(a, r, c, acc + bu[c]); }); }
    xcd_barrier(bar);
    p8_convgate(a, gt, NGT);
    xcd_barrier(bar);
    { float* R = (float*)(ws + WS_R); const float* X1 = (const float*)(ws + WS_X1); const float* bd = a.in[I_BDN];
      naive_gemm((const bf16*)(ws + WS_FF), (const bf16*)(ws + WS_WDN_T), MT, D, DFF, gw, NGW, lane, [&](int r, int c, float acc) { R[(size_t)r * D + c] = ALPHA * X1[(size_t)r * D + c] + acc + bd[c]; }); }
    xcd_barrier(bar);
    p_layernorm<false>(a, gw, NGW, lane);
}

extern "C" void kernel_launch(void* const* d_in, const int* in_sizes, int n_in, void* d_out, int out_size, void* d_ws, size_t ws_size, hipStream_t stream) {
    static int grid = 0;
    if (grid == 0) {
        if (n_in != N_IN || out_size != (int)O_END || ws_size < WS_END) { fprintf(stderr, "kernel_launch: unexpected shapes: n_in %d out %d ws %zu\n", n_in, out_size, ws_size); grid = -1; return; }
        int dev = 0, cus = 0, per_cu = 0;
        if (hipGetDevice(&dev) != hipSuccess || hipDeviceGetAttribute(&cus, hipDeviceAttributeMultiprocessorCount, dev) != hipSuccess) { grid = -1; return; }
        if (hipFuncSetAttribute((const void*)fwd_kernel, hipFuncAttributeMaxDynamicSharedMemorySize, LDS_BYTES) != hipSuccess) { fprintf(stderr, "kernel_launch: hipFuncSetAttribute failed\n"); grid = -1; return; }
        if (hipOccupancyMaxActiveBlocksPerMultiprocessor(&per_cu, (const void*)fwd_kernel, NTHR, LDS_BYTES) != hipSuccess || per_cu < 1) { fprintf(stderr, "kernel_launch: occupancy query says %d\n", per_cu); }
        (void)hipGetLastError();
        grid = cus;
    }
    if (grid < 0) return;
    if (hipMemsetAsync((char*)d_ws + WS_CTL, 0, CTL_ZERO_BYTES, stream) != hipSuccess) return;
    Args a{};
    for (int i = 0; i < N_IN; ++i) a.in[i] = (const float*)d_in[i];
    a.out = (float*)d_out; a.ws = (unsigned char*)d_ws;
    hipLaunchKernelGGL(fwd_kernel, dim3(grid), dim3(NTHR), LDS_BYTES, stream, a);
}
```

```cpp
#include <hip/hip_runtime.h>
#include <cstdio>
#include <cstdint>
namespace pg8 {
#define PG8_LAS __attribute__((address_space(3)))
typedef unsigned short bf16_t;
typedef short bf16x8 __attribute__((ext_vector_type(8)));
typedef float f32x4 __attribute__((ext_vector_type(4)));
typedef unsigned u32x4 __attribute__((ext_vector_type(4)));
constexpr int BM = 256, BK = 64, HALF = 128, HTB = HALF * BK * 2  , STAGE_BYTES = 8 * HTB, NXCD = 8, WGM = 8;

__host__ __device__ __forceinline__ int lds_byte(int r, int c) { const int st = (r >> 4) * 2 + (c >> 5), rr = r & 15, cc = c & 31, ob = rr * 64 + cc * 2; return st * 1024 + (ob ^ (((ob >> 9) & 1) << 5)); }
__host__ __device__ __forceinline__ void stage_rc(int b, int& R, int& C) { const int st = b / 1024, sb = b % 1024, swz = sb ^ (((sb >> 9) & 1) << 5); R = (st >> 1) * 16 + swz / 64; C = (st & 1) * 32 + (swz % 64) / 2; }
__host__ __device__ __forceinline__ int perm32(int rho) { const int n = rho >> 4, i = rho & 15; return 8 * (i >> 2) + 4 * n + (i & 3); }

struct Unit { int pm, pn; };
struct Gemm { const bf16_t* A; const bf16_t* Bt; int M, N, K; };

struct StaticOrder {
    int nM, nN, nwg, G, c;
    __host__ __device__ void init(int M, int N, int G_, int c_) { nM = M / BM; nN = N / BM; nwg = nM * nN; G = G_; c = c_; }
    __host__ __device__ bool next(int i, Unit& u) const {
        const long L = (long)i * G + c; if (L >= nwg) return false;
        int wgid = (int)L; { const int q = nwg / NXCD, r = nwg % NXCD, xcd = wgid % NXCD, off = wgid / NXCD; wgid = (xcd < r ? xcd * (q + 1) : r * (q + 1) + (xcd - r) * q) + off; }
        const int nig = WGM * nN, gid = wgid / nig, fm = gid * WGM, gsz = (nM - fm) < WGM ? (nM - fm) : WGM;
        u.pm = fm + ((wgid % nig) % gsz); u.pn = (wgid % nig) / gsz; return true;
    }
    __device__ __forceinline__ void a_ready(const Unit&) const {}
    __device__ __forceinline__ void done(const Unit&) const {}
};

__device__ __forceinline__ unsigned cvt_pk_bf16(float lo, float hi) { unsigned r; asm volatile("v_cvt_pk_bf16_f32 %0, %1, %2" : "=v"(r) : "v"(lo), "v"(hi)); return r; }
typedef float f32x2 __attribute__((ext_vector_type(2)));
__device__ __forceinline__ f32x2 gelu_pk(f32x2 v) {
    const f32x2 av = __builtin_elementwise_abs(v), d = av * 0.2316418882f + 1.0f;
    f32x2 t; t.x = __builtin_amdgcn_rcpf(d.x); t.y = __builtin_amdgcn_rcpf(d.y);
    f32x2 q = t * 0.5307027145f + (-0.7265760135f); q = q * t + 0.7107068705f; q = q * t + (-0.142248368f); q = q * t + 0.127414796f; q = q * t;
    const f32x2 s = (v * v) * (-0.72134752044f);
    f32x2 e; e.x = __builtin_amdgcn_exp2f(s.x); e.y = __builtin_amdgcn_exp2f(s.y);
    const f32x2 m = v * (q * e), r = v - m;
    f32x2 o; o.x = v.x < 0.f ? m.x : r.x; o.y = v.y < 0.f ? m.y : r.y; return o;
}

template <int ACT  > struct EpiBf16 {
    static constexpr bool PERM = true, AFTER_DRAIN = false; static_assert(ACT == 0 || ACT == 1, "EpiBf16: ACT is 0 (none) or 1 (gelu_pk)");
    bf16_t* O; int ldc; const float* bias; int split_cols; size_t split_stride; float scale0;
    __device__ __forceinline__ void operator()(const f32x4 (&acc)[2][2][4][2], const Unit& u, int wr, int wc, int fr, int fq) const {
        const int row0 = u.pm * BM + wr * 64 + fr; int colt = u.pn * BM; bf16_t* base = O;
        float sc = 1.f; if (split_cols) { const int t = colt / split_cols; base += (size_t)t * split_stride; colt -= t * split_cols; if (t == 0) sc = scale0; }
        const int col0 = colt + wc * 32 + 8 * fq, bcol0 = u.pn * BM + wc * 32 + 8 * fq;
        f32x4 bv[2][2];
#pragma unroll
        for (int bj = 0; bj < 2; ++bj)
#pragma unroll
            for (int n = 0; n < 2; ++n) bv[bj][n] = bias ? *(const f32x4*)(bias + bcol0 + bj * HALF + 4 * n) : (f32x4){0.f, 0.f, 0.f, 0.f};
#pragma unroll
        for (int ai = 0; ai < 2; ++ai)
#pragma unroll
            for (int m = 0; m < 4; ++m) { bf16_t* rowp = base + (size_t)(row0 + ai * HALF + m * 16) * ldc + col0;
#pragma unroll
                for (int bj = 0; bj < 2; ++bj) { f32x4 v0 = acc[ai][bj][m][0] + bv[bj][0], v1 = acc[ai][bj][m][1] + bv[bj][1];
                    if (ACT == 1) { f32x2 a = gelu_pk((f32x2){v0[0], v0[1]}), b = gelu_pk((f32x2){v0[2], v0[3]}), c = gelu_pk((f32x2){v1[0], v1[1]}), d = gelu_pk((f32x2){v1[2], v1[3]});
                        v0 = (f32x4){a.x, a.y, b.x, b.y}; v1 = (f32x4){c.x, c.y, d.x, d.y}; }
                    v0 = v0 * sc; v1 = v1 * sc; u32x4 w; w.x = cvt_pk_bf16(v0[0], v0[1]); w.y = cvt_pk_bf16(v0[2], v0[3]); w.z = cvt_pk_bf16(v1[0], v1[1]); w.w = cvt_pk_bf16(v1[2], v1[3]);
                    *(u32x4*)(rowp + bj * HALF) = w; } }
    }
};

struct PanelStats {
    unsigned* xbuf;
    unsigned* cnt;
    unsigned* tmo;
    int ntn; float eps;
    unsigned code;
    __device__ __forceinline__ bool run(const f32x4 (&v)[2][2][4][2], const Unit& u, int wr, int wc, int fr, int fq, PG8_LAS unsigned char* lds, int wid, int lane) const {
        typedef float f32x2v __attribute__((ext_vector_type(2)));
        PG8_LAS f32x2v* P = (PG8_LAS f32x2v*)lds;
        PG8_LAS f32x2v* S = (PG8_LAS f32x2v*)(lds + 8192);
        PG8_LAS unsigned* flag = (PG8_LAS unsigned*)(lds + 8192 + 2048);
#pragma unroll
        for (int ai = 0; ai < 2; ++ai)
#pragma unroll
            for (int m = 0; m < 4; ++m) {
                float s = 0.f;
#pragma unroll
                for (int bj = 0; bj < 2; ++bj)
#pragma unroll
                    for (int n = 0; n < 2; ++n) { const f32x4 x = v[ai][bj][m][n]; s += (x[0] + x[1]) + (x[2] + x[3]); }
                s += __shfl_xor(s, 16); s += __shfl_xor(s, 32);
                const float mw = s * (1.0f / 64.0f); float q = 0.f;
#pragma unroll
                for (int bj = 0; bj < 2; ++bj)
#pragma unroll
                    for (int n = 0; n < 2; ++n) { const f32x4 d = v[ai][bj][m][n] - mw; q += (d[0] * d[0] + d[1] * d[1]) + (d[2] * d[2] + d[3] * d[3]); }
                q += __shfl_xor(q, 16); q += __shfl_xor(q, 32);
                if (fq == 0) P[(ai * HALF + wr * 64 + m * 16 + fr) * 4 + wc] = (f32x2v){mw, q};
            }
        asm volatile("s_waitcnt lgkmcnt(0)" ::: "memory"); __builtin_amdgcn_s_barrier(); asm volatile("" ::: "memory");
#if defined(BROKEN_EXCHANGE_NO_WAIT)
#warning BROKEN CONTROL BUILD: the row-statistics exchange does not wait; results are wrong by design
        if (blockIdx.x >= 64) { const long long t0_ = clock64(); while (clock64() - t0_ < 60000) __builtin_amdgcn_s_sleep(8); }
#endif
        const int row = wid * 32 + (lane & 31);
        if (lane < 32) {
            const f32x2v a = P[row * 4 + 0], b = P[row * 4 + 1], c = P[row * 4 + 2], d = P[row * 4 + 3];
            const float mt = (a.x + b.x + c.x + d.x) * 0.25f;
            const float da = a.x - mt, db = b.x - mt, dc = c.x - mt, dd = d.x - mt;
            const float m2 = (a.y + b.y) + (c.y + d.y) + 64.0f * ((da * da + db * db) + (dc * dc + dd * dd));
            unsigned long long* slot = (unsigned long long*)xbuf + ((size_t)(u.pm * BM + row) * 4 + u.pn);
            __hip_atomic_store(slot, ((unsigned long long)__float_as_uint(m2) << 32) | __float_as_uint(mt), __ATOMIC_RELAXED, __HIP_MEMORY_SCOPE_AGENT);
        }
        asm volatile("s_waitcnt vmcnt(0)" ::: "memory");
        if (lane == 0) __hip_atomic_fetch_add(cnt + 64 * u.pm, 1u, __ATOMIC_RELAXED, __HIP_MEMORY_SCOPE_AGENT);
        if (wid == 0) {
            bool dead = false; const unsigned long long t0 = __builtin_amdgcn_s_memrealtime(); const unsigned want = 8u * (unsigned)ntn;
            for (;;) {
#if defined(BROKEN_EXCHANGE_NO_WAIT)
                break;
#endif
                if ((unsigned)__builtin_amdgcn_readfirstlane(__hip_atomic_load(cnt + 64 * u.pm, __ATOMIC_RELAXED, __HIP_MEMORY_SCOPE_AGENT)) >= want) break;
                if (__builtin_amdgcn_s_memrealtime() - t0 > 2000000ull) {
                    if (lane == 0) { unsigned expect = 0u; __hip_atomic_compare_exchange_strong(tmo + 1, &expect, code | (unsigned)(u.pm & 0xff), __ATOMIC_RELAXED, __ATOMIC_RELAXED, __HIP_MEMORY_SCOPE_AGENT);
                                     __hip_atomic_store(tmo, 1u, __ATOMIC_RELAXED, __HIP_MEMORY_SCOPE_AGENT); }
                    dead = true; break; }
                __builtin_amdgcn_s_sleep(2);
            }
            __builtin_amdgcn_fence(__ATOMIC_ACQUIRE, "agent");
            if (lane == 0) flag[0] = dead ? 1u : 0u;
        }
        asm volatile("s_waitcnt vmcnt(0) lgkmcnt(0)" ::: "memory"); __builtin_amdgcn_s_barrier(); asm volatile("" ::: "memory");
        const bool bad = flag[0] != 0u;
        if (lane < 32) {
            const unsigned long long* slot = (const unsigned long long*)xbuf + (size_t)(u.pm * BM + row) * 4; float mt[4], m2[4]; float ms = 0.f;
#pragma unroll
            for (int t = 0; t < 4; ++t) { if (t < ntn) { const unsigned long long w = __hip_atomic_load(slot + t, __ATOMIC_RELAXED, __HIP_MEMORY_SCOPE_AGENT); mt[t] = __uint_as_float((unsigned)w); m2[t] = __uint_as_float((unsigned)(w >> 32)); } else { mt[t] = 0.f; m2[t] = 0.f; } ms += mt[t]; }
            const float mean = ms / (float)ntn; float q = 0.f;
#pragma unroll
            for (int t = 0; t < 4; ++t) if (t < ntn) { const float dm = mt[t] - mean; q += m2[t] + 256.0f * dm * dm; }
            S[row] = (f32x2v){mean, 1.0f / sqrtf(q / (256.0f * (float)ntn) + eps)};
        }
        asm volatile("s_waitcnt lgkmcnt(0)" ::: "memory"); __builtin_amdgcn_s_barrier(); asm volatile("" ::: "memory");
        return bad;
    }
};
struct EpiLnRes {
    static constexpr bool PERM = false, AFTER_DRAIN = true;
    const float* base; float* out; int ldc; const float* bias; PanelStats st; unsigned poison;
    __device__ __forceinline__ void fused(f32x4 (&acc)[2][2][4][2], const Unit& u, int wr, int wc, int fr, int fq, PG8_LAS unsigned char* lds, int wid, int lane) const {
        typedef float f32x2v __attribute__((ext_vector_type(2)));
        const PG8_LAS f32x2v* S = (const PG8_LAS f32x2v*)(lds + 8192);
        const int col0 = u.pn * BM + wc * 32 + 4 * fq;
#pragma unroll
        for (int bj = 0; bj < 2; ++bj)
#pragma unroll
            for (int n = 0; n < 2; ++n) { const f32x4 bv = bias ? *(const f32x4*)(bias + col0 + bj * HALF + n * 16) : (f32x4){0.f, 0.f, 0.f, 0.f};
#pragma unroll
                for (int ai = 0; ai < 2; ++ai)
#pragma unroll
                    for (int m = 0; m < 4; ++m) acc[ai][bj][m][n] += bv; }
        f32x4 pre[4][2][2];
#pragma unroll
        for (int m = 0; m < 4; ++m) { const size_t off = (size_t)(u.pm * BM + wr * 64 + m * 16 + fr) * ldc + col0;
#pragma unroll
            for (int bj = 0; bj < 2; ++bj)
#pragma unroll
                for (int n = 0; n < 2; ++n) pre[m][bj][n] = *(const f32x4*)(base + off + bj * HALF + n * 16); }
        const bool bad = st.run(acc, u, wr, wc, fr, fq, lds, wid, lane) || poison != 0u;
        const float qnan = __builtin_nanf("");
#pragma unroll
        for (int ai = 0; ai < 2; ++ai)
#pragma unroll
            for (int m = 0; m < 4; ++m) { const int r = ai * HALF + wr * 64 + m * 16 + fr; const f32x2v sr = S[r]; const size_t off = (size_t)(u.pm * BM + r) * ldc + col0;
#pragma unroll
                for (int bj = 0; bj < 2; ++bj)
#pragma unroll
                    for (int n = 0; n < 2; ++n) { const f32x4 bs = ai == 0 ? pre[m][bj][n] : *(const f32x4*)(base + off + bj * HALF + n * 16); f32x4 o = bs + (acc[ai][bj][m][n] - sr.x) * sr.y;
                        if (bad) o = (f32x4){qnan, qnan, qnan, qnan}; *(f32x4*)(out + off + bj * HALF + n * 16) = o; }
                if (m & 1) asm volatile("" ::: "memory"); }
    }
};
struct EpiLnResLn {
    static constexpr bool PERM = false, AFTER_DRAIN = true;
    const float* base; float* out; bf16_t* xn; int ldc; const float* bias; PanelStats st1, st2; unsigned poison;
    __device__ __forceinline__ void fused(f32x4 (&acc)[2][2][4][2], const Unit& u, int wr, int wc, int fr, int fq, PG8_LAS unsigned char* lds, int wid, int lane) const {
        typedef float f32x2v __attribute__((ext_vector_type(2))); typedef unsigned u32x2v __attribute__((ext_vector_type(2)));
        const PG8_LAS f32x2v* S = (const PG8_LAS f32x2v*)(lds + 8192);
        const int col0 = u.pn * BM + wc * 32 + 4 * fq;
#pragma unroll
        for (int bj = 0; bj < 2; ++bj)
#pragma unroll
            for (int n = 0; n < 2; ++n) { const f32x4 bv = bias ? *(const f32x4*)(bias + col0 + bj * HALF + n * 16) : (f32x4){0.f, 0.f, 0.f, 0.f};
#pragma unroll
                for (int ai = 0; ai < 2; ++ai)
#pragma unroll
                    for (int m = 0; m < 4; ++m) acc[ai][bj][m][n] += bv; }
        bool bad = st1.run(acc, u, wr, wc, fr, fq, lds, wid, lane) || poison != 0u;
        const float qnan = __builtin_nanf("");
#pragma unroll
        for (int ai = 0; ai < 2; ++ai)
#pragma unroll
            for (int m = 0; m < 4; ++m) { const int r = ai * HALF + wr * 64 + m * 16 + fr; const f32x2v sr = S[r]; const size_t off = (size_t)(u.pm * BM + r) * ldc + col0;
#pragma unroll
                for (int bj = 0; bj < 2; ++bj)
#pragma unroll
                    for (int n = 0; n < 2; ++n) { const f32x4 bs = *(const f32x4*)(base + off + bj * HALF + n * 16); acc[ai][bj][m][n] = bs + (acc[ai][bj][m][n] - sr.x) * sr.y; }
                asm volatile("" : "+v"(acc[ai][0][m][0]), "+v"(acc[ai][0][m][1]), "+v"(acc[ai][1][m][0]), "+v"(acc[ai][1][m][1]));
                if (m & 1) asm volatile("" ::: "memory"); }
        const bool bad1 = bad;
        bad = st2.run(acc, u, wr, wc, fr, fq, lds, wid, lane) || bad;
#pragma unroll
        for (int ai = 0; ai < 2; ++ai)
#pragma unroll
            for (int m = 0; m < 4; ++m) { const int r = ai * HALF + wr * 64 + m * 16 + fr; const f32x2v sr = S[r]; const size_t off = (size_t)(u.pm * BM + r) * ldc + col0;
#pragma unroll
                for (int bj = 0; bj < 2; ++bj)
#pragma unroll
                    for (int n = 0; n < 2; ++n) { const f32x4 x1 = acc[ai][bj][m][n]; *(f32x4*)(out + off + bj * HALF + n * 16) = bad1 ? (f32x4){qnan, qnan, qnan, qnan} : x1;
                        const f32x4 o = (x1 - sr.x) * sr.y; u32x2v w; w.x = cvt_pk_bf16(o[0], o[1]); w.y = cvt_pk_bf16(o[2], o[3]);
                        if (bad) { w.x = 0x7fc07fc0u; w.y = 0x7fc07fc0u; } *(u32x2v*)(xn + off + bj * HALF + n * 16) = w; }
                asm volatile("" ::: "memory"); }
    }
};

template <class Epi, class Sched, bool ALIGN_EPI = false, bool SP2 = false>
__device__ __forceinline__ void gemm_phase(PG8_LAS unsigned char* lds, const Gemm g, const Sched& S, const Epi& E) {
    int tid_ = threadIdx.x; asm volatile("" : "+v"(tid_));
    const int tid = tid_, wid = __builtin_amdgcn_readfirstlane(tid >> 6), lane = tid & 63, wr = wid >> 2, wc = wid & 3, fr = lane & 15, fq = lane >> 4;
    const int K = g.K, nt = K / BK;
    unsigned voffA[2], voffB[2];
#pragma unroll
    for (int i = 0; i < 2; ++i) { int R, C; stage_rc(tid * 16 + i * 8192, R, C); const int Rb = Epi::PERM ? ((R & ~31) + perm32(R & 31)) : R;
        voffA[i] = (unsigned)(R * K + C) * 2u; voffB[i] = (unsigned)(Rb * K + C) * 2u; }
    const size_t kstep = (size_t)(BK * 2);
    const size_t hstep = (size_t)HALF * K * 2;
    const size_t tstep = 2 * hstep;
    const unsigned ldsw = (unsigned)wid * 1024u;
    const int aoff = lds_byte(wr * 64 + fr, fq * 8), boff = lds_byte(wc * 32 + fr, fq * 8);
#define PG8_SA(b, h) (((b) * 2 + (h)) * HTB)
#define PG8_SB(b, h) ((4 + (b) * 2 + (h)) * HTB)
#define PG8_STAGE(bufoff, gbase, voff) do { _Pragma("unroll") for (int _i = 0; _i < 2; ++_i) \
        __builtin_amdgcn_global_load_lds((const unsigned*)((const char*)(gbase) + (voff)[_i]), (PG8_LAS unsigned*)(lds + (bufoff) + ldsw + _i * 8192), 16, 0, 0); } while (0)
#define PG8_LDA(dst, b, h) do { _Pragma("unroll") for (int m = 0; m < 4; ++m) _Pragma("unroll") for (int k = 0; k < 2; ++k) dst[m][k] = *(const PG8_LAS bf16x8*)(lds + PG8_SA(b, h) + aoff + m * 2048 + k * 1024); } while (0)
#define PG8_LDB(dst, b, h) do { _Pragma("unroll") for (int n = 0; n < 2; ++n) _Pragma("unroll") for (int k = 0; k < 2; ++k) dst[n][k] = *(const PG8_LAS bf16x8*)(lds + PG8_SB(b, h) + boff + n * 2048 + k * 1024); } while (0)
#define PG8_MMA(ai, bj, At, Bt) do { __builtin_amdgcn_s_setprio(1); _Pragma("unroll") for (int m = 0; m < 4; ++m) _Pragma("unroll") for (int n = 0; n < 2; ++n) _Pragma("unroll") for (int k = 0; k < 2; ++k) \
        acc[ai][bj][m][n] = __builtin_amdgcn_mfma_f32_16x16x32_bf16(Bt[n][k], At[m][k], acc[ai][bj][m][n], 0, 0, 0); __builtin_amdgcn_s_setprio(0); } while (0)
#define PG8_WAIT_V(n) asm volatile("s_waitcnt vmcnt(" #n ")" ::: "memory")
#define PG8_WAIT_L(n) asm volatile("s_waitcnt lgkmcnt(" #n ")" ::: "memory")
#define PG8_BAR __builtin_amdgcn_s_barrier()
#define PG8_SCHED __builtin_amdgcn_sched_barrier(0)
    Unit cur, nxt; int ui = 0;
    if (!S.next(0, cur)) return;
    f32x4 acc[2][2][4][2];
#pragma unroll
    for (int a = 0; a < 2; ++a)
#pragma unroll
        for (int b = 0; b < 2; ++b)
#pragma unroll
            for (int m = 0; m < 4; ++m)
#pragma unroll
                for (int n = 0; n < 2; ++n) acc[a][b][m][n] = (f32x4){0.f, 0.f, 0.f, 0.f};
    bf16x8 At[4][2], B0[2][2], B1[2][2];
    const char* cA = (const char*)g.A + (size_t)cur.pm * tstep; const char* cB = (const char*)g.Bt + (size_t)cur.pn * tstep;
    S.a_ready(cur);
    if constexpr (SP2) {
        PG8_STAGE(PG8_SB(0, 0), cB, voffB); PG8_STAGE(PG8_SB(0, 1), cB + hstep, voffB); PG8_STAGE(PG8_SA(0, 0), cA, voffA); PG8_STAGE(PG8_SA(0, 1), cA + hstep, voffA);
        if (wr == 1) PG8_BAR;
        PG8_WAIT_V(2); PG8_BAR;
        PG8_STAGE(PG8_SB(1, 0), cB + kstep, voffB); PG8_STAGE(PG8_SA(1, 0), cA + kstep, voffA); PG8_STAGE(PG8_SB(1, 1), cB + hstep + kstep, voffB);
        PG8_WAIT_V(6); PG8_BAR;
    } else {
        PG8_STAGE(PG8_SB(0, 0), cB, voffB); PG8_STAGE(PG8_SA(0, 0), cA, voffA); PG8_STAGE(PG8_SB(0, 1), cB + hstep, voffB); PG8_STAGE(PG8_SA(0, 1), cA + hstep, voffA);
        if (wr == 1) PG8_BAR;
        PG8_WAIT_V(4); PG8_BAR;
        PG8_STAGE(PG8_SB(1, 0), cB + kstep, voffB); PG8_STAGE(PG8_SA(1, 0), cA + kstep, voffA); PG8_STAGE(PG8_SB(1, 1), cB + hstep + kstep, voffB);
        PG8_WAIT_V(6); PG8_BAR;
    }
    for (;;) {
        const bool has_next = S.next(ui + 1, nxt);
        const char* nA = has_next ? (const char*)g.A + (size_t)nxt.pm * tstep : cA; const char* nB = has_next ? (const char*)g.Bt + (size_t)nxt.pn * tstep : cB;
        for (int t = 0; t < nt; t += 2) {
            const bool last = (t == nt - 2);
            const char* a1 = cA + (size_t)(t + 1) * kstep;
            const char* a2 = last ? nA : cA + (size_t)(t + 2) * kstep; const char* b2 = last ? nB : cB + (size_t)(t + 2) * kstep;
            const char* a3 = a2 + kstep; const char* b3 = b2 + kstep;
            if (last && has_next) S.a_ready(nxt);
            if constexpr (SP2) {
            PG8_LDB(B0, 0, 0); PG8_LDB(B1, 0, 1); PG8_SCHED; PG8_LDA(At, 0, 0); PG8_STAGE(PG8_SA(1, 1), a1 + hstep, voffA);
            PG8_WAIT_V(8); PG8_WAIT_L(0); PG8_BAR; PG8_MMA(0, 0, At, B0); PG8_MMA(0, 1, At, B1); PG8_BAR; PG8_SCHED;
            PG8_LDA(At, 0, 1); PG8_STAGE(PG8_SB(0, 0), b2, voffB); PG8_STAGE(PG8_SB(0, 1), b2 + hstep, voffB); PG8_STAGE(PG8_SA(0, 0), a2, voffA);
            PG8_WAIT_V(8); PG8_WAIT_L(0); PG8_BAR; PG8_MMA(1, 0, At, B0); PG8_MMA(1, 1, At, B1); PG8_BAR; PG8_SCHED;
            PG8_LDB(B0, 1, 0); PG8_LDB(B1, 1, 1); PG8_SCHED; PG8_LDA(At, 1, 0); PG8_STAGE(PG8_SA(0, 1), a2 + hstep, voffA);
            PG8_WAIT_V(8); PG8_WAIT_L(0); PG8_BAR; PG8_MMA(0, 0, At, B0); PG8_MMA(0, 1, At, B1); PG8_BAR; PG8_SCHED;
            PG8_LDA(At, 1, 1); PG8_STAGE(PG8_SB(1, 0), b3, voffB); PG8_STAGE(PG8_SB(1, 1), b3 + hstep, voffB); PG8_STAGE(PG8_SA(1, 0), a3, voffA);
            PG8_WAIT_V(8); PG8_WAIT_L(0); PG8_BAR; PG8_MMA(1, 0, At, B0); PG8_MMA(1, 1, At, B1); PG8_BAR; PG8_SCHED;
            } else {
            PG8_LDB(B0, 0, 0); PG8_SCHED; PG8_LDA(At, 0, 0); PG8_STAGE(PG8_SA(1, 1), a1 + hstep, voffA);
            PG8_WAIT_L(8); PG8_BAR; PG8_WAIT_L(0); PG8_MMA(0, 0, At, B0); PG8_BAR; PG8_SCHED;
            PG8_LDB(B1, 0, 1); PG8_STAGE(PG8_SB(0, 0), b2, voffB);
            PG8_BAR; PG8_WAIT_L(0); PG8_MMA(0, 1, At, B1); PG8_BAR;
            PG8_LDA(At, 0, 1); PG8_STAGE(PG8_SA(0, 0), a2, voffA);
            PG8_BAR; PG8_WAIT_L(0); PG8_MMA(1, 0, At, B0); PG8_BAR; PG8_SCHED;
            PG8_STAGE(PG8_SB(0, 1), b2 + hstep, voffB);
            PG8_WAIT_V(6); PG8_BAR; PG8_MMA(1, 1, At, B1); PG8_BAR;
            PG8_LDB(B0, 1, 0); PG8_SCHED; PG8_LDA(At, 1, 0); PG8_STAGE(PG8_SA(0, 1), a2 + hstep, voffA);
            PG8_WAIT_L(8); PG8_BAR; PG8_WAIT_L(0); PG8_MMA(0, 0, At, B0); PG8_BAR; PG8_SCHED;
            PG8_LDB(B1, 1, 1); PG8_STAGE(PG8_SB(1, 0), b3, voffB);
            PG8_BAR; PG8_WAIT_L(0); PG8_MMA(0, 1, At, B1); PG8_BAR;
            PG8_LDA(At, 1, 1); PG8_STAGE(PG8_SA(1, 0), a3, voffA);
            PG8_BAR; PG8_WAIT_L(0); PG8_MMA(1, 0, At, B0); PG8_BAR; PG8_SCHED;
            PG8_STAGE(PG8_SB(1, 1), b3 + hstep, voffB);
            PG8_WAIT_V(6); PG8_BAR; PG8_MMA(1, 1, At, B1); PG8_BAR;
            }
        }
        if constexpr (ALIGN_EPI) { if (wr == 0) PG8_BAR; }
        if constexpr (!Epi::AFTER_DRAIN) { E(acc, cur, wr, wc, fr, fq); S.done(cur); }
        if (!has_next) break;
#pragma unroll
        for (int a = 0; a < 2; ++a)
#pragma unroll
            for (int b = 0; b < 2; ++b)
#pragma unroll
                for (int m = 0; m < 4; ++m)
#pragma unroll
                    for (int n = 0; n < 2; ++n) acc[a][b][m][n] = (f32x4){0.f, 0.f, 0.f, 0.f};
        cur = nxt; cA = nA; cB = nB; ++ui;
        if constexpr (ALIGN_EPI) { if (wr == 1) PG8_BAR; }
    }
    PG8_WAIT_V(0);
    if constexpr (!ALIGN_EPI) { if (wr == 0) PG8_BAR; }
    PG8_BAR;
    if constexpr (Epi::AFTER_DRAIN) { E.fused(acc, cur, wr, wc, fr, fq, lds, wid, lane); S.done(cur); }
#undef PG8_SA
#undef PG8_SB
#undef PG8_STAGE
#undef PG8_LDA
#undef PG8_LDB
#undef PG8_MMA
#undef PG8_WAIT_V
#undef PG8_WAIT_L
#undef PG8_BAR
#undef PG8_SCHED
}
}

#ifndef PG8_SP2
#define PG8_SP2 true
#endif
#ifndef PG8_ALIGN
#define PG8_ALIGN true
#endif
#define GAS __attribute__((address_space(1)))
#define LAS __attribute__((address_space(3)))
typedef unsigned short bf16;
typedef unsigned v4u __attribute__((ext_vector_type(4)));
typedef float f32x4 __attribute__((ext_vector_type(4)));
typedef short bf16x8 __attribute__((ext_vector_type(8)));
typedef GAS unsigned gu32;
typedef GAS unsigned long long gu64;
#define RLX_AGENT __ATOMIC_RELAXED, __HIP_MEMORY_SCOPE_AGENT
#define LDS_WAIT() asm volatile("s_waitcnt lgkmcnt(0)" ::: "memory")
#define VM_WAIT() asm volatile("s_waitcnt vmcnt(0)" ::: "memory")
__device__ __forceinline__ unsigned long long rt() { return __builtin_amdgcn_s_memrealtime(); }
__device__ __forceinline__ unsigned f2bf(float f) { unsigned u = __builtin_bit_cast(unsigned, f); return (u + 0x7fffu + ((u >> 16) & 1u)) >> 16; }
__device__ __forceinline__ unsigned pk2(float lo, float hi) { return f2bf(lo) | (f2bf(hi) << 16); }
#define XB_TMO      128
#define XB_XCNT(j)  (256  + 64 * (j))
#define XB_XSUB(j)  (1280 + 64 * (j))
#define XB_XGEN(j)  (2304 + 64 * (j))
#define XB_TOP      3328
#define XB_TOPGEN   3392
#define XCD_BAR_WORDS 3456
#define XB_SPIN_CAP (1u << 18)

__device__ __forceinline__ unsigned xb_ld(unsigned* p)              { return __hip_atomic_load(p, __ATOMIC_RELAXED, __HIP_MEMORY_SCOPE_AGENT); }
__device__ __forceinline__ unsigned xb_add(unsigned* p, unsigned v) { return __hip_atomic_fetch_add(p, v, __ATOMIC_RELAXED, __HIP_MEMORY_SCOPE_AGENT); }
__device__ __forceinline__ unsigned xb_xcc_id() { return (unsigned)__builtin_amdgcn_s_getreg((3 << 11) | 20) & 0xFu; }
#define XB_SPIN(cond, bar) do { unsigned _sp = 0; while (cond) { __builtin_amdgcn_s_sleep(1); \
    if ((++_sp & 255u) == 0u) { if (xb_ld(&(bar)[XB_TMO])) break; if (_sp > XB_SPIN_CAP) { atomicAdd(&(bar)[XB_TMO], 1u); break; } } } } while (0)

struct XcdBarrier {
    unsigned* bar; unsigned x;
    volatile LAS unsigned* st;
};

__device__ __forceinline__ XcdBarrier xcd_barrier_post(unsigned* bar, volatile LAS unsigned* st) {
    XcdBarrier b; b.bar = bar; b.x = xb_xcc_id(); b.st = st;
    if (threadIdx.x == 0) (void)xb_add(&bar[XB_XCNT(b.x)], 1u);
    return b;
}
__device__ __forceinline__ void xcd_barrier_complete(unsigned* bar, unsigned x, unsigned& nloc, unsigned& nx) {
    const unsigned G = gridDim.x * gridDim.y * gridDim.z;
    unsigned sum, cnt, mine, sp = 0u;
    for (;;) {
        sum = 0u; cnt = 0u; mine = 0u;
#pragma unroll
        for (unsigned j = 0; j < 16; ++j) { const unsigned c = xb_ld(&bar[XB_XCNT(j)]); sum += c; cnt += (c > 0u) ? 1u : 0u; mine = (j == x) ? c : mine; }
        if (sum == G) break;
        __builtin_amdgcn_s_sleep(1);
        if ((++sp & 255u) == 0u) { if (xb_ld(&bar[XB_TMO])) break; if (sp > XB_SPIN_CAP) { atomicAdd(&bar[XB_TMO], 1u); break; } }
    }
    nloc = mine > 0u ? mine : 1u; nx = cnt > 0u ? cnt : 1u;
}

__device__ __forceinline__ void xcd_barrier(const XcdBarrier& b) {
    asm volatile("s_waitcnt vmcnt(0)" ::: "memory");
    __syncthreads();
    if (threadIdx.x == 0) {
        unsigned* bar = b.bar;
        __builtin_amdgcn_s_waitcnt(0);
        unsigned nloc = b.st[0], nx = b.st[1];
        if (nloc == 0u) { xcd_barrier_complete(bar, b.x, nloc, nx); b.st[0] = nloc; b.st[1] = nx; }
        const unsigned old = xb_add(&bar[XB_XSUB(b.x)], 1u);
        const unsigned gen = old / nloc;
        if (old + 1u == (gen + 1u) * nloc) {
            __builtin_amdgcn_fence(__ATOMIC_RELEASE, "agent");
            asm volatile("s_waitcnt vmcnt(0)" ::: "memory");
            const unsigned og = xb_add(&bar[XB_TOP], 1u);
            const unsigned tg = og / nx;
            if (og + 1u == (tg + 1u) * nx) xb_add(&bar[XB_TOPGEN], 1u);
            else XB_SPIN(xb_ld(&bar[XB_TOPGEN]) == tg, bar);
            __builtin_amdgcn_fence(__ATOMIC_ACQUIRE, "agent");
            xb_add(&bar[XB_XGEN(b.x)], 1u);
            asm volatile("s_waitcnt vmcnt(0)" ::: "memory");
        } else {
            XB_SPIN(xb_ld(&bar[XB_XGEN(b.x)]) == gen, bar);
            __builtin_amdgcn_fence(__ATOMIC_ACQUIRE, "agent");
            asm volatile("s_waitcnt vmcnt(0)" ::: "memory");
        }
    }
    __syncthreads();
}
#ifndef FAST_MLSTM
#define FAST_MLSTM 1
#endif
#ifndef FAST_NSA
#define FAST_NSA 1
#endif
constexpr int NWAVES = 8, NTHR = 512;
constexpr int D = 1024, MP = 16384, MS = 128, MREAL = MP + MS, MT = 16640, NZ = 3584, DFF = 2688, NU = 5376;
constexpr int TP = 4096, BP = 4, BS = 32, TS = 4, PAST = 16384, NPAGES = 128, WPOS0_S = 15872;
constexpr float ALPHA = 1.189207115002721f, LN_EPS = 1e-5f;
constexpr int ZC_QK = 0, ZC_V = 1024, ZC_O = 1536, ZC_NQ = 2048, ZC_KV = 2560, ZC_WIN = 3072, ZC_G = 3328;
enum { I_XP = 0, I_XS, I_CKV, I_CWIN, I_SC, I_SN, I_SM, I_SMC, I_SFC, I_PT, I_WIN, I_BIN, I_MCW, I_MCB, I_MNW, I_POOL, I_RB, I_WOUT, I_LN1W, I_LN1B, I_WUP, I_BUP, I_FCW, I_FCB, I_WDN, I_BDN, I_LN2W, I_LN2B, N_IN };
constexpr size_t O_Y_P = 0, O_Y_S = O_Y_P + (size_t)MP * D, O_KV_P = O_Y_S + (size_t)MS * D, O_KV_S = O_KV_P + (size_t)MP * 512, O_WIN_P = O_KV_S + (size_t)MS * 512,
    O_WIN_S = O_WIN_P + (size_t)BP * 512 * 256, O_C_P = O_WIN_S + (size_t)BS * 512 * 256, O_C_S = O_C_P + (size_t)BP * 8 * 4096, O_N_P = O_C_S + (size_t)BS * 8 * 4096,
    O_N_S = O_N_P + BP * 8 * 64, O_M_P = O_N_S + BS * 8 * 64, O_M_S = O_M_P + BP * 8, O_MC_P = O_M_S + BS * 8, O_MC_S = O_MC_P + BP * 3 * 1024, O_FC_P = O_MC_S + BS * 3 * 1024,
    O_FC_S = O_FC_P + (size_t)BP * 2 * NU, O_END = O_FC_S + (size_t)BS * 2 * NU;
static_assert(O_END == 31777056, "output size");
constexpr size_t MiB = 1u << 20;
constexpr size_t WS_CTL = 0, CTL_ZERO_BYTES = 1 * MiB;
constexpr size_t WS_WIN_T = 2 * MiB, WS_WOUT_T = 10 * MiB, WS_WUP_T = 12 * MiB, WS_WDN_T = 24 * MiB, WS_ZB = 30 * MiB, WS_XB = 32 * MiB, WS_Z = 66 * MiB, WS_G = 180 * MiB,
    WS_QC = 186 * MiB, WS_H = 220 * MiB, WS_MIX = 254 * MiB, WS_R = 288 * MiB, WS_X1 = 354 * MiB, WS_X1B = 420 * MiB, WS_U = 454 * MiB, WS_FF = 626 * MiB, WS_KCS = 712 * MiB,
    WS_KCP = 728 * MiB, WS_US = 736 * MiB, WS_USN = 768 * MiB, WS_USS = 769 * MiB, WS_CS = 770 * MiB, WS_NK = 786 * MiB, WS_MK = 787 * MiB, WS_SVT = 788 * MiB, WS_WVT = 792 * MiB, WS_KCB = 796 * MiB, WS_VCT = 797 * MiB, WS_END = 798 * MiB;
constexpr int CW_BAR = 4096;

struct Args { const float* in[N_IN]; float* out; unsigned char* ws; };
typedef short bf16x8_t __attribute__((ext_vector_type(8)));
typedef float f32x16_t __attribute__((ext_vector_type(16)));
typedef unsigned u32x2_t __attribute__((ext_vector_type(2)));
__device__ __forceinline__ int xt_off(int r, int l) { return r * 128 + ((((l >> 3) ^ (r & 7))) << 4) + (l & 7) * 2; }


__device__ __forceinline__ float bf2f(bf16 v) { return __builtin_bit_cast(float, (unsigned)v << 16); }
__device__ __forceinline__ float sigmoidf_(float x) { return 1.f / (1.f + __expf(-x)); }
__device__ __forceinline__ float logsigmoidf_(float x) { return fminf(x, 0.f) - log1pf(__expf(-fabsf(x))); }
__device__ __forceinline__ float gelu_tanh(float x) { const float u = 0.7978845608028654f * (x + 0.044715f * x * x * x); return 0.5f * x * (1.f + tanhf(u)); }
__device__ __forceinline__ float wave_sum(float v) {
#pragma unroll
    for (int o = 1; o < 64; o <<= 1) v += __shfl_xor(v, o);
    return v;
}
__device__ __forceinline__ float wave_max(float v) {
#pragma unroll
    for (int o = 1; o < 64; o <<= 1) v = fmaxf(v, __shfl_xor(v, o));
    return v;
}
__device__ __forceinline__ int zcol_old(int c) {
    if (c < 2048) return c;
    if (c < 3328) return c + 16;
    if (c < 3344) return c - 1280;
    if (c < 3368) return c;
    return -1;
}
__device__ __forceinline__ int t5_bucket(int n) {
    if (n < 16) return n;
    const int v = 16 + (int)(logf((float)n * 0.0625f) / 2.0794415416798357f * 16.f);
    return v < 31 ? v : 31;
}

template <bool ZMAP> __device__ __forceinline__ void p0_transpose_item(const float* W, int K, int Nold, int N, bf16* WT, LAS float* scr, int item, int lane) {
    const int nblk = N / 32, kb = item / nblk, nb = item % nblk, k0 = 64 * kb, n0 = 32 * nb;
    const int ncol = n0 + (lane & 31); const int oc = ZMAP ? zcol_old(ncol) : ncol;
#pragma unroll 8
    for (int i = 0; i < 32; ++i) { const int kk = 2 * i + (lane >> 5); scr[kk * 33 + (lane & 31)] = (oc >= 0) ? W[(size_t)(k0 + kk) * Nold + oc] : 0.f; }
    LDS_WAIT(); asm volatile("" ::: "memory");
    const int c = lane & 7;
#pragma unroll
    for (int j = 0; j < 4; ++j) { const int n = (lane >> 3) + 8 * j; const LAS float* s = scr + (8 * c) * 33 + n;
        v4u o; o.x = pk2(s[0 * 33], s[1 * 33]); o.y = pk2(s[2 * 33], s[3 * 33]); o.z = pk2(s[4 * 33], s[5 * 33]); o.w = pk2(s[6 * 33], s[7 * 33]);
        *(GAS v4u*)(WT + (size_t)(n0 + n) * K + k0 + 8 * c) = o; }
    LDS_WAIT(); asm volatile("" ::: "memory");
}

__device__ __forceinline__ void p0_prologue(const Args& a, LAS unsigned char* lds, int gw, int NGW, int gt, int NGT, int wave, int lane) {
    unsigned char* ws = a.ws;
    LAS float* scr = (LAS float*)(lds + wave * 16384);
    constexpr int I_A = (D / 64) * (NZ / 32), I_B = (D / 64) * (D / 32), I_C = (D / 64) * (NU / 32), I_D = (DFF / 64) * (D / 32);
    for (int it = gw; it < I_A + I_B + I_C + I_D; it += NGW) {
        int r = it;
        if (r < I_A) { p0_transpose_item<true>(a.in[I_WIN], D, 3368, NZ, (bf16*)(ws + WS_WIN_T), scr, r, lane); continue; } r -= I_A;
        if (r < I_B) { p0_transpose_item<false>(a.in[I_WOUT], D, D, D, (bf16*)(ws + WS_WOUT_T), scr, r, lane); continue; } r -= I_B;
        if (r < I_C) { p0_transpose_item<false>(a.in[I_WUP], D, NU, NU, (bf16*)(ws + WS_WUP_T), scr, r, lane); continue; } r -= I_C;
        p0_transpose_item<false>(a.in[I_WDN], DFF, D, D, (bf16*)(ws + WS_WDN_T), scr, r, lane);
    }
    { float* zb = (float*)(ws + WS_ZB); const float* bin = a.in[I_BIN]; for (int c = gt; c < NZ; c += NGT) { const int oc = zcol_old(c); zb[c] = oc >= 0 ? bin[oc] : 0.f; } }
    { bf16* xb = (bf16*)(ws + WS_XB);
      for (int m = gw; m < MT; m += NGW) {
          GAS unsigned long long* o8 = (GAS unsigned long long*)(xb + (size_t)m * D) + lane;
          if (m < MREAL) { const float* xr = m < MP ? a.in[I_XP] + (size_t)m * D : a.in[I_XS] + (size_t)(m - MP) * D; const GAS f32x4* x4 = (const GAS f32x4*)xr + lane;
#pragma unroll
              for (int j = 0; j < 4; ++j) { const f32x4 v = x4[64 * j]; o8[64 * j] = (unsigned long long)pk2(v.x, v.y) | ((unsigned long long)pk2(v.z, v.w) << 32); } }
          else {
#pragma unroll
              for (int j = 0; j < 4; ++j) o8[64 * j] = 0ull; } } }
    { float* kcs = (float*)(ws + WS_KCS); const float* cache = a.in[I_CKV]; const int* pt = (const int*)a.in[I_PT]; const float* pw = a.in[I_POOL];
      const int e = lane >> 5, g = (lane >> 4) & 1;
      for (int u = gw; u < BS * 512; u += NGW) { const int b = u >> 9, c = u & 511; const int page = pt[b * NPAGES + (c >> 2)];
          const float* src = cache + ((size_t)page * 128 + (c & 3) * 32) * 512 + lane * 4; f32x4 acc = {0.f, 0.f, 0.f, 0.f};
#pragma unroll 8
          for (int j = 0; j < 32; ++j) { const f32x4 v = *(const GAS f32x4*)(src + (size_t)j * 512); const float w = pw[(e * 32 + j) * 2 + g]; acc += v * w; }
          *(GAS f32x4*)(kcs + (size_t)u * 256 + lane * 4) = acc; } }
    { const float* cw = a.in[I_CWIN]; float* wo = a.out + O_WIN_S;
      for (int i = gt; i < BS * 508 * 64; i += NGT) { const int b = i / (508 * 64), r = i % (508 * 64);
          *(GAS f32x4*)(wo + (size_t)b * 512 * 256 + (size_t)r * 4) = *(const GAS f32x4*)(cw + (size_t)b * 512 * 256 + 4 * 256 + (size_t)r * 4); } }
}

__device__ __forceinline__ void z_store1(const Args& a, int row, int col, float v) {
    ((bf16*)(a.ws + WS_Z))[(size_t)row * NZ + col] = (bf16)f2bf(v);
    if (row >= MREAL) return;
    const bool samp = row >= MP; const int b = samp ? (row - MP) >> 2 : row >> 12, t = samp ? (row - MP) & 3 : row & 4095;
    if (col < 1024) { if (!samp) { if (t >= TP - 3) a.out[O_MC_P + (size_t)(b * 3 + t - (TP - 3)) * 1024 + col] = v; } else if (t >= 1) a.out[O_MC_S + (size_t)(b * 3 + t - 1) * 1024 + col] = v; }
    else if (col >= ZC_KV && col < ZC_WIN) { const int c2 = col - ZC_KV; if (!samp) a.out[O_KV_P + (size_t)row * 512 + c2] = v; else a.out[O_KV_S + (size_t)(row - MP) * 512 + c2] = v; }
    else if (col >= ZC_WIN && col < ZC_G) { const int c2 = col - ZC_WIN; if (!samp) { if (t >= TP - 512) a.out[O_WIN_P + ((size_t)b * 512 + t - (TP - 512)) * 256 + c2] = v; } else a.out[O_WIN_S + ((size_t)b * 512 + 508 + t) * 256 + c2] = v; }
    else if (col >= ZC_G && col < ZC_G + 64) ((float*)(a.ws + WS_G))[(size_t)row * 64 + col - ZC_G] = v;
}
__device__ __forceinline__ void u_store1(const Args& a, int row, int col, float v) {
    ((bf16*)(a.ws + WS_U))[(size_t)row * NU + col] = (bf16)f2bf(v);
    if (row >= MREAL) return;
    const bool samp = row >= MP; const int b = samp ? (row - MP) >> 2 : row >> 12, t = samp ? (row - MP) & 3 : row & 4095;
    if (!samp) { if (t >= TP - 2) a.out[O_FC_P + (size_t)(b * 2 + t - (TP - 2)) * NU + col] = v; } else if (t >= 2) a.out[O_FC_S + (size_t)(b * 2 + t - 2) * NU + col] = v;
}

template <class F> __device__ __forceinline__ void naive_gemm(const bf16* A, const bf16* Bt, int M, int N, int K, int gw, int NGW, int lane, const F& f) {
    const int nct = N / 8, total = (M / 8) * nct;
    for (int u = gw; u < total; u += NGW) {
        const int r = (u / nct) * 8 + (lane >> 3), c = (u % nct) * 8 + (lane & 7);
        const GAS v4u* ap = (const GAS v4u*)(A + (size_t)r * K); const GAS v4u* bp = (const GAS v4u*)(Bt + (size_t)c * K);
        float acc = 0.f;
        for (int k = 0; k < K / 8; ++k) { const v4u x = ap[k], y = bp[k];
            acc += __builtin_bit_cast(float, x.x << 16) * __builtin_bit_cast(float, y.x << 16) + __builtin_bit_cast(float, x.x & 0xffff0000u) * __builtin_bit_cast(float, y.x & 0xffff0000u);
            acc += __builtin_bit_cast(float, x.y << 16) * __builtin_bit_cast(float, y.y << 16) + __builtin_bit_cast(float, x.y & 0xffff0000u) * __builtin_bit_cast(float, y.y & 0xffff0000u);
            acc += __builtin_bit_cast(float, x.z << 16) * __builtin_bit_cast(float, y.z << 16) + __builtin_bit_cast(float, x.z & 0xffff0000u) * __builtin_bit_cast(float, y.z & 0xffff0000u);
            acc += __builtin_bit_cast(float, x.w << 16) * __builtin_bit_cast(float, y.w << 16) + __builtin_bit_cast(float, x.w & 0xffff0000u) * __builtin_bit_cast(float, y.w & 0xffff0000u); }
        f(r, c, acc);
    }
}


struct EpiZ {
    static constexpr bool PERM = true, AFTER_DRAIN = false;
    float* out; unsigned char* ws;
    __device__ __forceinline__ void operator()(const pg8::f32x4 (&acc)[2][2][4][2], const pg8::Unit& u, int wr, int wc, int fr, int fq) const {
        const int pn = u.pn, col0 = pn * 256 + wc * 32 + 8 * fq; bf16* Z = (bf16*)(ws + WS_Z); const float* zb = (const float*)(ws + WS_ZB);
        f32x4 bv[2][2];
#pragma unroll
        for (int bj = 0; bj < 2; ++bj)
#pragma unroll
            for (int n = 0; n < 2; ++n) bv[bj][n] = *(const GAS f32x4*)(zb + col0 + bj * 128 + 4 * n);
#pragma unroll
        for (int ai = 0; ai < 2; ++ai)
#pragma unroll
            for (int m = 0; m < 4; ++m) { const int row = u.pm * 256 + wr * 64 + fr + ai * 128 + m * 16;
                const bool real = row < MREAL, samp = row >= MP; const int b = samp ? (row - MP) >> 2 : row >> 12, t = samp ? (row - MP) & 3 : row & 4095;
#pragma unroll
                for (int bj = 0; bj < 2; ++bj) { const int col = col0 + bj * 128; const f32x4 v0 = acc[ai][bj][m][0] + bv[bj][0], v1 = acc[ai][bj][m][1] + bv[bj][1];
                    v4u w; w.x = pk2(v0.x, v0.y); w.y = pk2(v0.z, v0.w); w.z = pk2(v1.x, v1.y); w.w = pk2(v1.z, v1.w);
                    *(GAS v4u*)(Z + (size_t)row * NZ + col) = w;
                    float* dst = nullptr;
                    if (real) {
                        if (pn < 4) { if (!samp) { if (t >= TP - 3) dst = out + O_MC_P + (size_t)(b * 3 + t - (TP - 3)) * 1024 + col; } else if (t >= 1) dst = out + O_MC_S + (size_t)(b * 3 + t - 1) * 1024 + col; }
                        else if (pn == 10 || pn == 11) dst = (!samp ? out + O_KV_P + (size_t)row * 512 : out + O_KV_S + (size_t)(row - MP) * 512) + (col - ZC_KV);
                        else if (pn == 12) { if (!samp) { if (t >= TP - 512) dst = out + O_WIN_P + ((size_t)b * 512 + t - (TP - 512)) * 256 + (col - ZC_WIN); } else dst = out + O_WIN_S + ((size_t)b * 512 + 508 + t) * 256 + (col - ZC_WIN); }
                        else if (pn == 13) { if (col - ZC_G < 64) dst = (float*)(ws + WS_G) + (size_t)row * 64 + (col - ZC_G); }
                    }
                    if (dst) { *(GAS f32x4*)dst = v0; *(GAS f32x4*)(dst + 4) = v1; } } }
    }
};
struct EpiU {
    static constexpr bool PERM = true, AFTER_DRAIN = false;
    float* out; unsigned char* ws; const float* bias;
    __device__ __forceinline__ void operator()(const pg8::f32x4 (&acc)[2][2][4][2], const pg8::Unit& u, int wr, int wc, int fr, int fq) const {
        const int col0 = u.pn * 256 + wc * 32 + 8 * fq; bf16* U = (bf16*)(ws + WS_U);
        f32x4 bv[2][2];
#pragma unroll
        for (int bj = 0; bj < 2; ++bj)
#pragma unroll
            for (int n = 0; n < 2; ++n) bv[bj][n] = *(const GAS f32x4*)(bias + col0 + bj * 128 + 4 * n);
#pragma unroll
        for (int ai = 0; ai < 2; ++ai)
#pragma unroll
            for (int m = 0; m < 4; ++m) { const int row = u.pm * 256 + wr * 64 + fr + ai * 128 + m * 16;
                const bool real = row < MREAL, samp = row >= MP; const int b = samp ? (row - MP) >> 2 : row >> 12, t = samp ? (row - MP) & 3 : row & 4095;
                float* drow = nullptr;
                if (real) { if (!samp) { if (t >= TP - 2) drow = out + O_FC_P + (size_t)(b * 2 + t - (TP - 2)) * NU; } else if (t >= 2) drow = out + O_FC_S + (size_t)(b * 2 + t - 2) * NU; }
#pragma unroll
                for (int bj = 0; bj < 2; ++bj) { const int col = col0 + bj * 128; const f32x4 v0 = acc[ai][bj][m][0] + bv[bj][0], v1 = acc[ai][bj][m][1] + bv[bj][1];
                    v4u w; w.x = pk2(v0.x, v0.y); w.y = pk2(v0.z, v0.w); w.z = pk2(v1.x, v1.y); w.w = pk2(v1.z, v1.w);
                    *(GAS v4u*)(U + (size_t)row * NU + col) = w;
                    if (drow) { *(GAS f32x4*)(drow + col) = v0; *(GAS f32x4*)(drow + col + 4) = v1; } } }
    }
};
template <bool FIRST> struct EpiRes {
    static constexpr bool PERM = false, AFTER_DRAIN = false;
    const float* xp; const float* xs; const float* x1; const float* bias; float* R;
    __device__ __forceinline__ void operator()(const pg8::f32x4 (&acc)[2][2][4][2], const pg8::Unit& u, int wr, int wc, int fr, int fq) const {
        const int col0 = u.pn * 256 + wc * 32 + 4 * fq;
        f32x4 bv[2][2];
#pragma unroll
        for (int bj = 0; bj < 2; ++bj)
#pragma unroll
            for (int n = 0; n < 2; ++n) bv[bj][n] = FIRST ? (f32x4){0.f, 0.f, 0.f, 0.f} : *(const GAS f32x4*)(bias + col0 + bj * 128 + n * 16);
#pragma unroll
        for (int ai = 0; ai < 2; ++ai)
#pragma unroll
            for (int m = 0; m < 4; ++m) { const int row = u.pm * 256 + wr * 64 + fr + ai * 128 + m * 16;
                const float* brow = FIRST ? (row < MP ? xp + (size_t)row * D : (row < MREAL ? xs + (size_t)(row - MP) * D : nullptr)) : x1 + (size_t)row * D;
#pragma unroll
                for (int bj = 0; bj < 2; ++bj)
#pragma unroll
                    for (int n = 0; n < 2; ++n) { const int col = col0 + bj * 128 + n * 16; const f32x4 bs = brow ? *(const GAS f32x4*)(brow + col) : (f32x4){0.f, 0.f, 0.f, 0.f};
                        *(GAS f32x4*)(R + (size_t)row * D + col) = bs * ALPHA + acc[ai][bj][m][n] + bv[bj][n]; }
                asm volatile("" ::: "memory"); }
    }
};

__device__ __forceinline__ void p2_conv_pool(const Args& a, int gw, int NGW, int gt, int NGT, int lane) {
    const bf16* Z = (const bf16*)(a.ws + WS_Z); bf16* QC = (bf16*)(a.ws + WS_QC);
    const float* cw = a.in[I_MCW]; const float* cb = a.in[I_MCB]; const float* smc = a.in[I_SMC];
    for (int i = gt; i < MREAL * 1024; i += NGT) { const int row = i >> 10, c = i & 1023;
        const bool samp = row >= MP; const int b = samp ? (row - MP) >> 2 : row >> 12, t = samp ? (row - MP) & 3 : row & 4095;
        float acc = cb[c];
#pragma unroll
        for (int j = 0; j < 4; ++j) { const int tt = t - 3 + j; float v;
            if (tt >= 0) v = bf2f(Z[(size_t)(row - 3 + j) * NZ + c]); else v = samp ? smc[(size_t)(b * 3 + 3 + tt) * 1024 + c] : 0.f;
            acc += cw[j * 1024 + c] * v; }
        float s = acc * sigmoidf_(acc); if (c >= 512) s *= 0.125f;
        QC[(size_t)row * 1024 + c] = (bf16)f2bf(s); }
    { float* kcp = (float*)(a.ws + WS_KCP); const float* kv = a.out + O_KV_P; const float* pw = a.in[I_POOL]; const int e = lane >> 5, g = (lane >> 4) & 1;
      for (int u = gw; u < BP * 128; u += NGW) { const int b = u >> 7, c = u & 127; const float* src = kv + ((size_t)b * TP + c * 32) * 512 + lane * 4; f32x4 acc = {0.f, 0.f, 0.f, 0.f};
#pragma unroll 8
          for (int j = 0; j < 32; ++j) { const f32x4 v = *(const GAS f32x4*)(src + (size_t)j * 512); const float w = pw[(e * 32 + j) * 2 + g]; acc += v * w; }
          *(GAS f32x4*)(kcp + (size_t)u * 256 + lane * 4) = acc;
          const int d4 = (lane & 15) * 4;
          if (e == 0) { u32x2_t o; o.x = pk2(acc.x, acc.y); o.y = pk2(acc.z, acc.w); *(GAS u32x2_t*)((bf16*)(a.ws + WS_KCB) + ((size_t)(b * 2 + g) * 128 + c) * 64 + d4) = o; }
          else { bf16* vt = (bf16*)(a.ws + WS_VCT) + ((size_t)(b * 2 + g) * 64 + d4) * 128 + c; vt[0] = (bf16)f2bf(acc.x); vt[128] = (bf16)f2bf(acc.y); vt[256] = (bf16)f2bf(acc.z); vt[384] = (bf16)f2bf(acc.w); } } }
}
__device__ __forceinline__ void p2_vtrans(const Args& a, LAS unsigned char* wl, int gw, int NGW, int lane) {
    const bf16* Z = (const bf16*)(a.ws + WS_Z);
    for (int u = gw; u < 2 * BP * 2 * 64; u += NGW) { const int which = u >> 9, b = (u >> 7) & 3, g = (u >> 6) & 1, tile = u & 63;
        const bf16* src = Z + ((size_t)b * TP + tile * 64 + lane) * NZ + (which ? ZC_WIN + 128 : ZC_KV + 384) + g * 64;
        bf16* dst = (bf16*)(a.ws + (which ? WS_WVT : WS_SVT)) + (size_t)(b * 2 + g) * 64 * TP + tile * 64;
#pragma unroll 2
        for (int p = 0; p < 8; ++p) { const v4u v8 = *(const GAS v4u*)(src + p * 8); const unsigned vw[4] = {v8.x, v8.y, v8.z, v8.w};
#pragma unroll
            for (int q = 0; q < 4; ++q) { const int r = p * 8 + 2 * q;
                *(LAS unsigned short*)(wl + xt_off(r, lane)) = (unsigned short)(vw[q] & 0xffffu); *(LAS unsigned short*)(wl + xt_off(r + 1, lane)) = (unsigned short)(vw[q] >> 16); } }
        LDS_WAIT(); asm volatile("" ::: "memory");
#pragma unroll 2
        for (int p = 0; p < 8; ++p) { const int id = p * 64 + lane, d = id >> 3, k8 = id & 7;
            *(GAS v4u*)(dst + (size_t)d * TP + k8 * 8) = *(const LAS v4u*)(wl + d * 128 + ((k8 ^ (d & 7)) << 4)); }
        LDS_WAIT(); asm volatile("" ::: "memory"); }
}

__device__ __forceinline__ void mlstm_chain(const Args& a, bool samp, int b, int h, int tid) {
    const bf16* Z = (const bf16*)(a.ws + WS_Z); const bf16* QC = (const bf16*)(a.ws + WS_QC); const float* G = (const float*)(a.ws + WS_G); float* H = (float*)(a.ws + WS_H);
    const int e = tid >> 3, dq = tid & 7; const int T = samp ? TS : TP; const int rowbase = samp ? MP + b * TS : b * TP;
    float C[8], n[8]; float m;
#pragma unroll
    for (int i = 0; i < 8; ++i) { C[i] = samp ? a.in[I_SC][((size_t)(b * 8 + h) * 64 + e) * 64 + dq * 8 + i] : 0.f; n[i] = samp ? a.in[I_SN][(size_t)(b * 8 + h) * 64 + dq * 8 + i] : 0.f; }
    m = samp ? a.in[I_SM][b * 8 + h] : 0.f;
    for (int t = 0; t < T; ++t) { const size_t row = (size_t)rowbase + t;
        const v4u q8 = *(const GAS v4u*)(QC + row * 1024 + h * 64 + dq * 8), k8 = *(const GAS v4u*)(QC + row * 1024 + 512 + h * 64 + dq * 8);
        const float v = bf2f(Z[row * NZ + ZC_V + h * 64 + e]); const float ig = G[row * 64 + h], fg = G[row * 64 + 8 + h];
        float q[8], k[8];
        q[0] = __builtin_bit_cast(float, q8.x << 16); q[1] = __builtin_bit_cast(float, q8.x & 0xffff0000u); q[2] = __builtin_bit_cast(float, q8.y << 16); q[3] = __builtin_bit_cast(float, q8.y & 0xffff0000u);
        q[4] = __builtin_bit_cast(float, q8.z << 16); q[5] = __builtin_bit_cast(float, q8.z & 0xffff0000u); q[6] = __builtin_bit_cast(float, q8.w << 16); q[7] = __builtin_bit_cast(float, q8.w & 0xffff0000u);
        k[0] = __builtin_bit_cast(float, k8.x << 16); k[1] = __builtin_bit_cast(float, k8.x & 0xffff0000u); k[2] = __builtin_bit_cast(float, k8.y << 16); k[3] = __builtin_bit_cast(float, k8.y & 0xffff0000u);
        k[4] = __builtin_bit_cast(float, k8.z << 16); k[5] = __builtin_bit_cast(float, k8.z & 0xffff0000u); k[6] = __builtin_bit_cast(float, k8.w << 16); k[7] = __builtin_bit_cast(float, k8.w & 0xffff0000u);
        const float lf = logsigmoidf_(fg); const float mn = fmaxf(lf + m, ig); const float fs = __expf(lf + m - mn), is = __expf(ig - mn);
        float pn = 0.f, pd = 0.f;
#pragma unroll
        for (int i = 0; i < 8; ++i) { C[i] = fs * C[i] + is * v * k[i]; n[i] = fs * n[i] + is * k[i]; pn += C[i] * q[i]; pd += n[i] * q[i]; }
        pn += __shfl_xor(pn, 1); pn += __shfl_xor(pn, 2); pn += __shfl_xor(pn, 4);
        pd += __shfl_xor(pd, 1); pd += __shfl_xor(pd, 2); pd += __shfl_xor(pd, 4);
        const float den = fmaxf(fabsf(pd), __expf(-mn));
        if (dq == 0) H[row * 512 + h * 64 + e] = pn / den;
        m = mn; }
    float* co = a.out + (samp ? O_C_S : O_C_P) + ((size_t)(b * 8 + h) * 64 + e) * 64 + dq * 8;
#pragma unroll
    for (int i = 0; i < 8; ++i) co[i] = C[i];
    if (e == 0) { float* no = a.out + (samp ? O_N_S : O_N_P) + (size_t)(b * 8 + h) * 64 + dq * 8;
#pragma unroll
        for (int i = 0; i < 8; ++i) no[i] = n[i]; }
    if (tid == 0) a.out[(samp ? O_M_S : O_M_P) + b * 8 + h] = m;
}


__device__ __forceinline__ float wave_scan_add(float v, int lane) {
#pragma unroll
    for (int o = 1; o < 64; o <<= 1) { const float t = __shfl_up(v, o); if (lane >= o) v += t; }
    return v;
}
__device__ __forceinline__ float wave_scan_max(float v, int lane) {
#pragma unroll
    for (int o = 1; o < 64; o <<= 1) { const float t = __shfl_up(v, o); if (lane >= o) v = fmaxf(v, t); }
    return v;
}
__device__ __forceinline__ unsigned pkbf(float lo, float hi) { return pk2(lo, hi); }
#define MFMA32(A, B, C) __builtin_amdgcn_mfma_f32_32x32x16_bf16((A), (B), (C), 0, 0, 0)
__device__ __forceinline__ void mlstm_passA(const Args& a, LAS unsigned char* wl, LAS float* W, int unit, int lane) {
    const bf16* Z = (const bf16*)(a.ws + WS_Z); const bf16* QC = (const bf16*)(a.ws + WS_QC); const float* G = (const float*)(a.ws + WS_G);
    const int b = unit >> 9, h = (unit >> 6) & 7, k = unit & 63; const size_t row0 = (size_t)b * TP + k * 64;
    const int l32 = lane & 31, hi = lane >> 5;
    LAS unsigned char* KT = wl; LAS unsigned char* VT = wl + 8192;
    const float ig = G[(row0 + lane) * 64 + h], fg = G[(row0 + lane) * 64 + 8 + h];
    const float bcum = wave_scan_add(logsigmoidf_(fg), lane); const float bend = __shfl(bcum, 63);
    const float dec = bend - bcum + ig; const float mloc = wave_max(dec); const float w = __expf(dec - mloc);
    W[lane] = w;
    { const bf16* kr = QC + (row0 + lane) * 1024 + 512 + h * 64; const bf16* vr = Z + (row0 + lane) * NZ + ZC_V + h * 64;
#pragma unroll 2
      for (int p = 0; p < 8; ++p) { const v4u k8 = *(const GAS v4u*)(kr + p * 8), v8 = *(const GAS v4u*)(vr + p * 8); const unsigned kw[4] = {k8.x, k8.y, k8.z, k8.w}, vw[4] = {v8.x, v8.y, v8.z, v8.w};
#pragma unroll
          for (int q = 0; q < 4; ++q) { const int r = p * 8 + 2 * q;
              *(LAS unsigned short*)(KT + xt_off(r, lane)) = (unsigned short)(kw[q] & 0xffffu); *(LAS unsigned short*)(KT + xt_off(r + 1, lane)) = (unsigned short)(kw[q] >> 16);
              const unsigned pv = pkbf(__builtin_bit_cast(float, vw[q] << 16) * w, __builtin_bit_cast(float, vw[q] & 0xffff0000u) * w);
              *(LAS unsigned short*)(VT + xt_off(r, lane)) = (unsigned short)(pv & 0xffffu); *(LAS unsigned short*)(VT + xt_off(r + 1, lane)) = (unsigned short)(pv >> 16); } } }
    LDS_WAIT(); asm volatile("" ::: "memory");
    float nu = 0.f;
#pragma unroll 2
    for (int c = 0; c < 8; ++c) { const v4u kk = *(const LAS v4u*)(KT + lane * 128 + ((c ^ (lane & 7)) << 4)); const unsigned kw[4] = {kk.x, kk.y, kk.z, kk.w};
#pragma unroll
        for (int q = 0; q < 4; ++q) nu += W[c * 8 + 2 * q] * __builtin_bit_cast(float, kw[q] << 16) + W[c * 8 + 2 * q + 1] * __builtin_bit_cast(float, kw[q] & 0xffff0000u); }
    f32x16_t acc[2][2];
#pragma unroll
    for (int i = 0; i < 2; ++i)
#pragma unroll
        for (int j = 0; j < 2; ++j) acc[i][j] = (f32x16_t){0.f, 0.f, 0.f, 0.f, 0.f, 0.f, 0.f, 0.f, 0.f, 0.f, 0.f, 0.f, 0.f, 0.f, 0.f, 0.f};
#pragma unroll
    for (int st = 0; st < 4; ++st) { bf16x8_t A[2], B[2];
#pragma unroll
        for (int i = 0; i < 2; ++i) { const int r = l32 + 32 * i; const int off = r * 128 + (((2 * st + hi) ^ (r & 7)) << 4); A[i] = *(const LAS bf16x8_t*)(VT + off); B[i] = *(const LAS bf16x8_t*)(KT + off); }
#pragma unroll
        for (int i = 0; i < 2; ++i)
#pragma unroll
            for (int j = 0; j < 2; ++j) acc[i][j] = MFMA32(A[i], B[j], acc[i][j]); }
    float* US = (float*)(a.ws + WS_US) + (size_t)unit * 4096;
#pragma unroll
    for (int i = 0; i < 2; ++i)
#pragma unroll
        for (int j = 0; j < 2; ++j)
#pragma unroll
            for (int r = 0; r < 16; ++r) { const int e = 32 * i + (r & 3) + 8 * (r >> 2) + 4 * hi, d = 32 * j + l32; US[e * 64 + d] = acc[i][j][r]; }
    ((float*)(a.ws + WS_USN))[(size_t)unit * 64 + lane] = nu;
    if (lane == 0) { float* ss = (float*)(a.ws + WS_USS) + unit * 2; ss[0] = bend; ss[1] = mloc; }
    LDS_WAIT(); asm volatile("" ::: "memory");
}
__device__ __forceinline__ void mlstm_scan(const Args& a, int gt, int NGT) {
    for (int idx = gt; idx < BP * 8 * 4096; idx += NGT) { const int bh = idx >> 12, el = idx & 4095;
        const float* US = (const float*)(a.ws + WS_US) + (size_t)bh * 64 * 4096 + el; const float* USN = (const float*)(a.ws + WS_USN) + (size_t)bh * 64 * 64 + el;
        const float* USS = (const float*)(a.ws + WS_USS) + bh * 128; bf16* CS = (bf16*)(a.ws + WS_CS) + (size_t)bh * 64 * 4096 + el;
        float* NK = (float*)(a.ws + WS_NK) + (size_t)bh * 64 * 64 + el; float* MK = (float*)(a.ws + WS_MK) + bh * 64;
        float C = 0.f, n = 0.f, m = 0.f; const bool hasn = el < 64;
        for (int k0 = 0; k0 < 64; k0 += 8) { float u[8], un[8];
#pragma unroll
            for (int j = 0; j < 8; ++j) { u[j] = US[(size_t)(k0 + j) * 4096]; un[j] = hasn ? USN[(k0 + j) * 64] : 0.f; }
#pragma unroll
            for (int j = 0; j < 8; ++j) { const int k = k0 + j; const float be = USS[2 * k], ml = USS[2 * k + 1];
                CS[(size_t)k * 4096] = (bf16)f2bf(C); if (hasn) NK[k * 64] = n; if (el == 0) MK[k] = m;
                const float m1 = fmaxf(be + m, ml); const float fC = __expf(be + m - m1), fU = __expf(ml - m1);
                C = fC * C + fU * u[j]; n = fC * n + fU * un[j]; m = m1; } }
        a.out[O_C_P + (size_t)bh * 4096 + el] = C; if (hasn) a.out[O_N_P + bh * 64 + el] = n; if (el == 0) a.out[O_M_P + bh] = m; }
}
__device__ __forceinline__ void mlstm_passC(const Args& a, LAS unsigned char* wl, int unit, int lane) {
    const bf16* Z = (const bf16*)(a.ws + WS_Z); const bf16* QC = (const bf16*)(a.ws + WS_QC); const float* G = (const float*)(a.ws + WS_G); bf16* MIX = (bf16*)(a.ws + WS_MIX);
    const int b = unit >> 9, h = (unit >> 6) & 7, k = unit & 63; const size_t row0 = (size_t)b * TP + k * 64;
    const int l32 = lane & 31, hi = lane >> 5;
    LAS unsigned char* VT = wl; LAS float* GS = (LAS float*)(wl + 8192); LAS float* BSm = GS + 64; LAS float* ML = BSm + 64; LAS float* NS = ML + 64; LAS float* NW = NS + 64;
    const float mk = ((const float*)(a.ws + WS_MK))[unit];
    { const float ig = G[(row0 + lane) * 64 + h], fg = G[(row0 + lane) * 64 + 8 + h];
      const float bcum = wave_scan_add(logsigmoidf_(fg), lane); const float g = ig - bcum; const float pm = wave_scan_max(g, lane);
      GS[lane] = g; BSm[lane] = bcum; ML[lane] = fmaxf(mk, pm); NS[lane] = ((const float*)(a.ws + WS_NK))[(size_t)unit * 64 + lane]; NW[lane] = a.in[I_MNW][h * 64 + lane]; }
    { const bf16* vr = Z + (row0 + lane) * NZ + ZC_V + h * 64;
#pragma unroll 2
      for (int p = 0; p < 8; ++p) { const v4u v8 = *(const GAS v4u*)(vr + p * 8); const unsigned vw[4] = {v8.x, v8.y, v8.z, v8.w};
#pragma unroll
          for (int q = 0; q < 4; ++q) { const int r = p * 8 + 2 * q;
              *(LAS unsigned short*)(VT + xt_off(r, lane)) = (unsigned short)(vw[q] & 0xffffu); *(LAS unsigned short*)(VT + xt_off(r + 1, lane)) = (unsigned short)(vw[q] >> 16); } } }
    bf16x8_t qf[2][4], xf[2][4];
#pragma unroll
    for (int i = 0; i < 2; ++i)
#pragma unroll
        for (int st = 0; st < 4; ++st) { qf[i][st] = *(const GAS bf16x8_t*)(QC + (row0 + l32 + 32 * i) * 1024 + h * 64 + 16 * st + 8 * hi);
            xf[i][st] = *(const GAS bf16x8_t*)((const bf16*)(a.ws + WS_CS) + (size_t)unit * 4096 + (l32 + 32 * i) * 64 + 16 * st + 8 * hi); }
    f32x16_t num[2][2];
#pragma unroll
    for (int i = 0; i < 2; ++i)
#pragma unroll
        for (int j = 0; j < 2; ++j) { num[i][j] = (f32x16_t){0.f, 0.f, 0.f, 0.f, 0.f, 0.f, 0.f, 0.f, 0.f, 0.f, 0.f, 0.f, 0.f, 0.f, 0.f, 0.f};
#pragma unroll
            for (int st = 0; st < 4; ++st) num[i][j] = MFMA32(xf[i][st], qf[j][st], num[i][j]); }
    LDS_WAIT(); asm volatile("" ::: "memory");
    float nq[2], Ml[2], bl[2], wint[2];
#pragma unroll
    for (int j = 0; j < 2; ++j) { float s = 0.f;
#pragma unroll
        for (int st = 0; st < 4; ++st) { const v4u qq = __builtin_bit_cast(v4u, qf[j][st]); const unsigned qw[4] = {qq.x, qq.y, qq.z, qq.w};
#pragma unroll
            for (int q = 0; q < 4; ++q) { const int d = 16 * st + 8 * hi + 2 * q; s += NS[d] * __builtin_bit_cast(float, qw[q] << 16) + NS[d + 1] * __builtin_bit_cast(float, qw[q] & 0xffff0000u); } }
        nq[j] = s + __shfl_xor(s, 32); Ml[j] = ML[l32 + 32 * j]; bl[j] = BSm[l32 + 32 * j]; wint[j] = __expf(mk - Ml[j]); }
#pragma unroll
    for (int i = 0; i < 2; ++i)
#pragma unroll
        for (int j = 0; j < 2; ++j) num[i][j] *= wint[j];
#pragma unroll
    for (int i = 0; i < 2; ++i)
#pragma unroll
        for (int st = 0; st < 4; ++st) xf[i][st] = *(const GAS bf16x8_t*)(QC + (row0 + l32 + 32 * i) * 1024 + 512 + h * 64 + 16 * st + 8 * hi);
    float cs[2] = {0.f, 0.f};
#pragma unroll
    for (int blk = 0; blk < 3; ++blk) { const int sb = blk == 2 ? 1 : 0, lb = blk == 0 ? 0 : 1;
        f32x16_t S = (f32x16_t){0.f, 0.f, 0.f, 0.f, 0.f, 0.f, 0.f, 0.f, 0.f, 0.f, 0.f, 0.f, 0.f, 0.f, 0.f, 0.f};
#pragma unroll
        for (int st = 0; st < 4; ++st) S = MFMA32(xf[sb][st], qf[lb][st], S);
#pragma unroll
        for (int r = 0; r < 16; ++r) { const int srow = (r & 3) + 8 * (r >> 2) + 4 * hi; const float gs = GS[32 * sb + srow]; const bool valid = (sb < lb) || (srow <= l32);
            const float av = valid ? S[r] * __expf(gs - Ml[lb]) : 0.f; S[r] = av; cs[lb] += av; }
#pragma unroll
        for (int sp = 0; sp < 2; ++sp) { bf16x8_t P; { v4u pw; pw.x = pkbf(S[8 * sp + 0], S[8 * sp + 1]); pw.y = pkbf(S[8 * sp + 2], S[8 * sp + 3]); pw.z = pkbf(S[8 * sp + 4], S[8 * sp + 5]); pw.w = pkbf(S[8 * sp + 6], S[8 * sp + 7]); P = __builtin_bit_cast(bf16x8_t, pw); }
#pragma unroll
            for (int i = 0; i < 2; ++i) { const int e = l32 + 32 * i; const int ch = 4 * sb + 2 * sp;
                const u32x2_t lo = *(const LAS u32x2_t*)(VT + e * 128 + ((ch ^ (e & 7)) << 4) + 8 * hi), hh = *(const LAS u32x2_t*)(VT + e * 128 + (((ch + 1) ^ (e & 7)) << 4) + 8 * hi);
                v4u aw; aw.x = lo.x; aw.y = lo.y; aw.z = hh.x; aw.w = hh.y;
                num[i][lb] = MFMA32(__builtin_bit_cast(bf16x8_t, aw), P, num[i][lb]); } } }
    LDS_WAIT(); asm volatile("" ::: "memory");
#pragma unroll
    for (int j = 0; j < 2; ++j) { const float csum = cs[j] + __shfl_xor(cs[j], 32); float den = csum + wint[j] * nq[j]; den = fmaxf(fabsf(den), __expf(-(bl[j] + Ml[j]))); const float rden = 1.f / den;
        float s1 = 0.f;
#pragma unroll
        for (int i = 0; i < 2; ++i)
#pragma unroll
            for (int r = 0; r < 16; ++r) { num[i][j][r] *= rden; s1 += num[i][j][r]; }
        s1 += __shfl_xor(s1, 32); const float mu = s1 * (1.f / 64.f); float s2 = 0.f;
#pragma unroll
        for (int i = 0; i < 2; ++i)
#pragma unroll
            for (int r = 0; r < 16; ++r) { const float dv = num[i][j][r] - mu; num[i][j][r] = dv; s2 += dv * dv; }
        s2 += __shfl_xor(s2, 32); const float rstd = 1.f / sqrtf(s2 * (1.f / 64.f) + LN_EPS); const int l = l32 + 32 * j;
#pragma unroll
        for (int i = 0; i < 2; ++i)
#pragma unroll
            for (int r4 = 0; r4 < 4; ++r4) { const int e0 = 32 * i + 8 * r4 + 4 * hi; const f32x4 nwv = *(const LAS f32x4*)(NW + e0);
                u32x2_t o; o.x = pkbf(num[i][j][4 * r4] * rstd * nwv.x, num[i][j][4 * r4 + 1] * rstd * nwv.y); o.y = pkbf(num[i][j][4 * r4 + 2] * rstd * nwv.z, num[i][j][4 * r4 + 3] * rstd * nwv.w);
                *(LAS u32x2_t*)(VT + l * 128 + (((e0 >> 3) ^ (l & 7)) << 4) + (e0 & 7) * 2) = o; } }
    LDS_WAIT(); asm volatile("" ::: "memory");
#pragma unroll 2
    for (int p = 0; p < 8; ++p) { const int id = p * 64 + lane, l = id >> 3, c8 = id & 7; const v4u hv = *(const LAS v4u*)(VT + l * 128 + ((c8 ^ (l & 7)) << 4));
        const v4u ov = *(const GAS v4u*)(Z + (row0 + l) * NZ + ZC_O + h * 64 + c8 * 8); const unsigned hw[4] = {hv.x, hv.y, hv.z, hv.w}, ow[4] = {ov.x, ov.y, ov.z, ov.w}; unsigned rw[4];
#pragma unroll
        for (int q = 0; q < 4; ++q) rw[q] = pkbf(sigmoidf_(__builtin_bit_cast(float, ow[q] << 16)) * __builtin_bit_cast(float, hw[q] << 16), sigmoidf_(__builtin_bit_cast(float, ow[q] & 0xffff0000u)) * __builtin_bit_cast(float, hw[q] & 0xffff0000u));
        v4u res; res.x = rw[0]; res.y = rw[1]; res.z = rw[2]; res.w = rw[3];
        *(GAS v4u*)(MIX + (row0 + l) * 1024 + h * 64 + c8 * 8) = res; }
    LDS_WAIT(); asm volatile("" ::: "memory");
}

constexpr int SCP = 1040;
struct NsaLds { LAS float *BT, *QS, *SC, *IMP, *RED, *OACC, *STAT; LAS int* LIST; };
__device__ __forceinline__ NsaLds nsa_lds(LAS unsigned char* lds) { NsaLds L; L.BT = (LAS float*)lds; L.QS = L.BT + 1024; L.SC = L.QS + 256; L.IMP = L.SC + 4 * SCP; L.LIST = (LAS int*)(L.IMP + 272); L.RED = (LAS float*)(L.LIST + 32); L.OACC = L.RED + 2048; L.STAT = L.OACC + 768; return L; }
__device__ __forceinline__ void nsa_softmax_stats(const NsaLds& L, int n, int wave, int lane) {
    if (wave < 4) { LAS float* s = L.SC + wave * SCP; float mx = -INFINITY;
        for (int i = lane; i < n; i += 64) mx = fmaxf(mx, s[i]);
        mx = wave_max(mx); if (!(mx > -INFINITY)) mx = 0.f;
        float sum = 0.f;
        for (int i = lane; i < n; i += 64) { const float ev = __expf(s[i] - mx); s[i] = ev; sum += ev; }
        sum = wave_sum(sum); if (lane == 0) L.STAT[wave] = 1.f / fmaxf(sum, 1e-30f); }
}
template <class VF> __device__ __forceinline__ void nsa_pv(const NsaLds& L, int n, int br, int tid, const VF& vf) {
    const int sl = tid >> 6, d = tid & 63; float a0 = 0.f, a1 = 0.f, a2 = 0.f, a3 = 0.f;
    for (int i = sl; i < n; i += 8) { const float p0 = L.SC[i], p1 = L.SC[SCP + i], p2 = L.SC[2 * SCP + i], p3 = L.SC[3 * SCP + i];
        if (p0 != 0.f || p1 != 0.f || p2 != 0.f || p3 != 0.f) { const float v = vf(i, d); a0 += p0 * v; a1 += p1 * v; a2 += p2 * v; a3 += p3 * v; } }
    L.RED[sl * 256 + d] = a0; L.RED[sl * 256 + 64 + d] = a1; L.RED[sl * 256 + 128 + d] = a2; L.RED[sl * 256 + 192 + d] = a3;
    __syncthreads();
    if (tid < 256) { float s = 0.f;
#pragma unroll
        for (int k = 0; k < 8; ++k) s += L.RED[k * 256 + tid];
        L.OACC[br * 256 + tid] = s * L.STAT[tid >> 6]; }
    __syncthreads();
}
__device__ __forceinline__ void dot64x4(const float* kr, const LAS float* q, float (&s)[4]) {
    s[0] = s[1] = s[2] = s[3] = 0.f;
#pragma unroll 4
    for (int i = 0; i < 16; ++i) { const f32x4 kv = *(const GAS f32x4*)(kr + 4 * i);
#pragma unroll
        for (int h = 0; h < 4; ++h) { const LAS float* qq = q + h * 64 + 4 * i; s[h] += kv.x * qq[0] + kv.y * qq[1] + kv.z * qq[2] + kv.w * qq[3]; } }
}
__device__ __forceinline__ void nsa_bias_table(const Args& a, const NsaLds& L, int tid) {
    for (int i = tid; i < 1024; i += NTHR) { const int hd = i >> 7, n = i & 127; const float v = a.in[I_RB][t5_bucket(n) * 8 + hd]; L.BT[i] = v; }
    __syncthreads();
}
__device__ __forceinline__ void nsa_unit(const Args& a, const NsaLds& L, bool samp, int b, int g, int tl, int tid, int wave, int lane) {
    const bf16* Z = (const bf16*)(a.ws + WS_Z); const float* G = (const float*)(a.ws + WS_G);
    const int t = samp ? PAST + tl : tl; const size_t row = samp ? (size_t)MP + b * TS + tl : (size_t)b * TP + tl;
    const float* kc = samp ? (const float*)(a.ws + WS_KCS) + (size_t)b * 512 * 256 : (const float*)(a.ws + WS_KCP) + (size_t)b * 128 * 256;
    const int* pt = (const int*)a.in[I_PT] + b * NPAGES;
    if (tid < 256) L.QS[tid] = bf2f(Z[row * NZ + ZC_NQ + g * 256 + tid]) * 0.125f;
    __syncthreads();
    const int ncv = samp ? 512 : ((t + 1) >> 5);
    for (int c = tid; c < ncv; c += NTHR) { const float* kr = kc + (size_t)c * 256 + g * 64; const int dist = t - 32 * c - 31; const int dn = dist < 127 ? dist : 127;
        float s4[4]; dot64x4(kr, L.QS, s4);
#pragma unroll
        for (int h = 0; h < 4; ++h) L.SC[h * SCP + c] = s4[h] + L.BT[(g * 4 + h) * 128 + dn]; }
    __syncthreads();
    nsa_softmax_stats(L, ncv, wave, lane);
    __syncthreads();
    const int cur = t >> 6;
    for (int j = tid; j < cur; j += NTHR) { float s = 0.f;
#pragma unroll
        for (int h = 0; h < 4; ++h) s += L.STAT[h] * L.SC[h * SCP + 2 * j] + L.STAT[h] * L.SC[h * SCP + 2 * j + 1];
        L.IMP[j] = s; }
    nsa_pv(L, ncv, 0, tid, [&](int i, int d) { return kc[(size_t)i * 256 + 128 + g * 64 + d]; });
    const int nsb = cur < 15 ? cur + 1 : 16;
    if (cur <= 15) { if (tid <= cur) L.LIST[tid] = tid; }
    else { if (tid == 0) L.LIST[0] = cur;
        for (int j = tid; j < cur; j += NTHR) { const float v = L.IMP[j]; int rank = 0;
            for (int k = 0; k < cur; ++k) { const float w = L.IMP[k]; rank += (w > v || (w == v && k < j)) ? 1 : 0; }
            if (rank < 15) L.LIST[1 + rank] = j; } }
    __syncthreads();
    const int nks = nsb * 64;
    auto sel_row = [&](int idx, bool& valid) -> const float* { const int blk = L.LIST[idx >> 6], pos = blk * 64 + (idx & 63); valid = pos <= t;
        if (!samp) return a.out + O_KV_P + ((size_t)b * TP + pos) * 512;
        if (pos >= PAST) return a.out + O_KV_S + (size_t)(b * TS + (valid ? pos - PAST : 0)) * 512;
        return a.in[I_CKV] + ((size_t)pt[pos >> 7] * 128 + (pos & 127)) * 512; };
    for (int idx = tid; idx < nks; idx += NTHR) { bool valid; const float* r = sel_row(idx, valid); const int pos = L.LIST[idx >> 6] * 64 + (idx & 63); const int dist = t - pos; const int dn = dist < 127 ? dist : 127;
        if (valid) { float s4[4]; dot64x4(r + 256 + g * 64, L.QS, s4);
#pragma unroll
            for (int h = 0; h < 4; ++h) L.SC[h * SCP + idx] = s4[h] + L.BT[(g * 4 + h) * 128 + dn]; }
        else {
#pragma unroll
            for (int h = 0; h < 4; ++h) L.SC[h * SCP + idx] = -INFINITY; } }
    __syncthreads();
    nsa_softmax_stats(L, nks, wave, lane);
    __syncthreads();
    nsa_pv(L, nks, 1, tid, [&](int i, int d) { bool valid; const float* r = sel_row(i, valid); return valid ? r[384 + g * 64 + d] : 0.f; });
    const int lo = (t - 512 > (samp ? WPOS0_S : 0)) ? t - 512 : (samp ? WPOS0_S : 0); const int nkw = t - lo + 1;
    for (int i = tid; i < nkw; i += NTHR) { const int pos = lo + i; const int dist = t - pos; const int dn = dist < 127 ? dist : 127; float s[4];
        if (!samp) { const bf16* kr = Z + ((size_t)b * TP + pos) * NZ + ZC_WIN + g * 64; s[0] = s[1] = s[2] = s[3] = 0.f;
#pragma unroll 2
            for (int d8 = 0; d8 < 8; ++d8) { const v4u kk = *(const GAS v4u*)(kr + d8 * 8); const unsigned w[4] = {kk.x, kk.y, kk.z, kk.w};
#pragma unroll
                for (int p = 0; p < 4; ++p) { const float k0 = __builtin_bit_cast(float, w[p] << 16), k1 = __builtin_bit_cast(float, w[p] & 0xffff0000u);
#pragma unroll
                    for (int h = 0; h < 4; ++h) s[h] += k0 * L.QS[h * 64 + d8 * 8 + 2 * p] + k1 * L.QS[h * 64 + d8 * 8 + 2 * p + 1]; } } }
        else { const float* kr = pos < PAST ? a.in[I_CWIN] + ((size_t)(b * 512 + pos - WPOS0_S) * 2) * 128 + g * 64 : a.out + O_WIN_S + ((size_t)b * 512 + 508 + pos - PAST) * 256 + g * 64;
            dot64x4(kr, L.QS, s); }
#pragma unroll
        for (int h = 0; h < 4; ++h) L.SC[h * SCP + i] = s[h] + L.BT[(g * 4 + h) * 128 + dn]; }
    __syncthreads();
    nsa_softmax_stats(L, nkw, wave, lane);
    __syncthreads();
    nsa_pv(L, nkw, 2, tid, [&](int i, int d) { const int pos = lo + i;
        if (!samp) return bf2f(Z[((size_t)b * TP + pos) * NZ + ZC_WIN + 128 + g * 64 + d]);
        return pos < PAST ? a.in[I_CWIN][((size_t)(b * 512 + pos - WPOS0_S) * 2 + 1) * 128 + g * 64 + d] : a.out[O_WIN_S + ((size_t)b * 512 + 508 + pos - PAST) * 256 + 128 + g * 64 + d]; });
    if (tid < 256) { const int hd = g * 4 + (tid >> 6); const float* gr = G + row * 64 + 16 + hd;
        const float v = sigmoidf_(gr[0]) * L.OACC[tid] + sigmoidf_(gr[8]) * L.OACC[256 + tid] + sigmoidf_(gr[16]) * L.OACC[512 + tid];
        ((bf16*)(a.ws + WS_MIX))[row * 1024 + 512 + g * 256 + tid] = (bf16)f2bf(v); }
    __syncthreads();
}


constexpr int NL_BT2 = 0, NL_SELM = 4096, NL_KV = 4608, KVP = 144, KVT = 64 * KVP, KVB = 2 * KVT, NL_IMPH = NL_KV + 2 * KVB, NL_IMP = NL_IMPH + 4 * 64 * 65 * 4, NL_END = NL_IMP + 64 * 65 * 4, IMPP = 65;
static_assert(NL_END <= 131072, "NSA LDS map");
#define F16Z (f32x16_t){0.f, 0.f, 0.f, 0.f, 0.f, 0.f, 0.f, 0.f, 0.f, 0.f, 0.f, 0.f, 0.f, 0.f, 0.f, 0.f}
__device__ __forceinline__ void nsa_stage_store(LAS unsigned char* buf, int tid, v4u kreg, v4u vreg) {
    const int r = tid >> 3, c8 = tid & 7; const int off = r * KVP + c8 * 16;
    *(LAS v4u*)(buf + off) = kreg; *(LAS v4u*)(buf + KVT + off) = vreg;
}
constexpr float NSA_C1 = 0.125f * 1.4426950408889634f;
__device__ __forceinline__ f32x16_t nsa_qk_half(const LAS unsigned char* buf, const bf16x8_t (&qf)[4], int kb, int l32, int hi) {
    f32x16_t S = F16Z; const LAS unsigned char* base = buf + l32 * KVP + hi * 16;
#pragma unroll
    for (int st = 0; st < 4; ++st) { const bf16x8_t A = *(const LAS bf16x8_t*)(base + kb * 32 * KVP + st * 32); S = MFMA32(A, qf[st], S); }
    return S;
}
__device__ __forceinline__ void nsa_pv_half(const LAS unsigned char* vt, const f32x16_t& P, f32x16_t (&O)[2], int kb, int l32, int hi) {
#pragma unroll
    for (int sp = 0; sp < 2; ++sp) { v4u pw; pw.x = pk2(P[8 * sp + 0], P[8 * sp + 1]); pw.y = pk2(P[8 * sp + 2], P[8 * sp + 3]); pw.z = pk2(P[8 * sp + 4], P[8 * sp + 5]); pw.w = pk2(P[8 * sp + 6], P[8 * sp + 7]);
        const bf16x8_t Pb = __builtin_bit_cast(bf16x8_t, pw); const int ch = 4 * kb + 2 * sp; const LAS unsigned char* base = vt + l32 * KVP + 8 * hi;
#pragma unroll
        for (int db = 0; db < 2; ++db) {
            const u32x2_t lo = *(const LAS u32x2_t*)(base + db * 32 * KVP + ch * 16), hh = *(const LAS u32x2_t*)(base + db * 32 * KVP + ch * 16 + 16);
            v4u aw; aw.x = lo.x; aw.y = lo.y; aw.z = hh.x; aw.w = hh.y;
            O[db] = MFMA32(__builtin_bit_cast(bf16x8_t, aw), Pb, O[db]); } }
}
template <int MODE> __device__ __forceinline__ void nsa_tile(const LAS unsigned char* buf, const bf16x8_t (&qf)[4], f32x16_t (&O)[2], float& m2, float& l, int j, int qt, int jfirst, int t, bool lanesel, const LAS float* BTh, float bfar, int l32, int hi) {
    const bool general = (j > qt - 3) || (MODE == 2 && j == jfirst);
#pragma unroll
    for (int kb = 0; kb < 2; ++kb) { f32x16_t S = nsa_qk_half(buf, qf, kb, l32, hi);
        if (general) { float mx = -INFINITY;
#pragma unroll
            for (int r = 0; r < 16; ++r) { const int pos = 64 * j + 32 * kb + (r & 3) + 8 * (r >> 2) + 4 * hi; const int dist = t - pos;
                const bool valid = lanesel && dist >= 0 && (MODE == 1 || dist <= 512); const int dn = dist < 0 ? 0 : (dist > 127 ? 127 : dist);
                const float y = valid ? S[r] * NSA_C1 + BTh[dn] : -INFINITY; S[r] = y; mx = fmaxf(mx, y); }
            mx = fmaxf(mx, __shfl_xor(mx, 32));
            if (__any(mx > m2)) { const float mn = fmaxf(m2, mx); const float alpha = __builtin_amdgcn_exp2f(m2 - mn); m2 = mn; l *= alpha; O[0] *= alpha; O[1] *= alpha; }
#pragma unroll
            for (int r = 0; r < 16; ++r) { const float p = __builtin_amdgcn_exp2f(S[r] - m2); S[r] = p; l += p; } }
        else { const float c0 = lanesel ? bfar : -INFINITY; float mx = fmaxf(S[0], S[1]);
#pragma unroll
            for (int r = 2; r < 16; ++r) mx = fmaxf(mx, S[r]);
            mx = mx * NSA_C1 + c0; mx = fmaxf(mx, __shfl_xor(mx, 32));
            if (__any(mx > m2)) { const float mn = fmaxf(m2, mx); const float alpha = __builtin_amdgcn_exp2f(m2 - mn); m2 = mn; l *= alpha; O[0] *= alpha; O[1] *= alpha; }
            const float c2 = c0 - m2;
#pragma unroll
            for (int r = 0; r < 16; ++r) { const float p = __builtin_amdgcn_exp2f(S[r] * NSA_C1 + c2); S[r] = p; l += p; } }
        nsa_pv_half(buf + KVT, S, O, kb, l32, hi);
        asm volatile("" ::: "memory"); }
}
template <int MODE> __device__ __forceinline__ void nsa_run_tiles(const bf16* Kg, const bf16* VTg, LAS unsigned char* KV, int j0, int j1, const bf16x8_t (&qf)[4], f32x16_t (&O)[2], float& m, float& l, int qt, int t,
                                                                   unsigned long long selm, const LAS float* BTh, float bfar, int tid, int l32, int hi) {
    const int sr = tid >> 3, sc8 = tid & 7;
    v4u kreg = *(const GAS v4u*)(Kg + (size_t)(64 * j0 + sr) * NZ + sc8 * 8), vreg = *(const GAS v4u*)(VTg + (size_t)sr * TP + 64 * j0 + sc8 * 8);
    nsa_stage_store(KV, tid, kreg, vreg);
    __syncthreads();
    for (int j = j0; j <= j1; ++j) { const int cur = (j - j0) & 1;
        if (j < j1) { kreg = *(const GAS v4u*)(Kg + (size_t)(64 * (j + 1) + sr) * NZ + sc8 * 8); vreg = *(const GAS v4u*)(VTg + (size_t)sr * TP + 64 * (j + 1) + sc8 * 8); }
        const bool lanesel = MODE == 1 ? ((selm >> j) & 1ull) != 0ull : true;
        if (__any(lanesel)) nsa_tile<MODE>(KV + cur * KVB, qf, O, m, l, j, qt, j0, t, lanesel, BTh, bfar, l32, hi);
        if (j < j1) nsa_stage_store(KV + (cur ^ 1) * KVB, tid, kreg, vreg);
        __syncthreads(); }
}
__device__ __forceinline__ void nsa_p_unit(const Args& a, LAS unsigned char* lds, int b, int g, int qt, int tid_in, int wave) {
    const bf16* Z = (const bf16*)(a.ws + WS_Z); const float* G = (const float*)(a.ws + WS_G);
    int tid = tid_in; asm volatile("" : "+v"(tid));
    const int lane = tid & 63;
    const int l32 = lane & 31, hi = lane >> 5, jj = wave >> 1, qh = wave & 1, hd = g * 4 + jj;
    const int t = qt * 64 + 32 * qh + l32; const size_t row = (size_t)b * TP + t;
    const LAS float* BTh = (const LAS float*)(lds + NL_BT2) + hd * 128; const float bfar = BTh[127];
    LAS unsigned char* KV = lds + NL_KV; LAS float* IMPH = (LAS float*)(lds + NL_IMPH); LAS float* IMP = (LAS float*)(lds + NL_IMP);
    bf16x8_t qf[4];
#pragma unroll
    for (int st = 0; st < 4; ++st) qf[st] = *(const GAS bf16x8_t*)(Z + row * NZ + ZC_NQ + hd * 64 + 16 * st + 8 * hi);
    const float gc = sigmoidf_(G[row * 64 + 16 + hd]), gs = sigmoidf_(G[row * 64 + 24 + hd]), gw = sigmoidf_(G[row * 64 + 32 + hd]);
    f32x16_t tot[2];
    const int ntile = qt >= 32 ? 2 : 1;
    { const int sr = tid >> 3, sc8 = tid & 7; const bf16* kcb = (const bf16*)(a.ws + WS_KCB) + (size_t)(b * 2 + g) * 128 * 64; const bf16* vct = (const bf16*)(a.ws + WS_VCT) + (size_t)(b * 2 + g) * 64 * 128;
#pragma unroll
      for (int tl = 0; tl < 2; ++tl) if (tl < ntile) nsa_stage_store(KV + tl * KVB, tid, *(const GAS v4u*)(kcb + (size_t)(64 * tl + sr) * 64 + sc8 * 8), *(const GAS v4u*)(vct + (size_t)sr * 128 + 64 * tl + sc8 * 8)); }
    __syncthreads();
    { const int ncv = (t + 1) >> 5; float m2 = -1e30f, lsum = 0.f;
#pragma unroll
      for (int tl = 0; tl < 2; ++tl) if (tl < ntile) {
#pragma unroll
          for (int cb = 0; cb < 2; ++cb) { f32x16_t S = nsa_qk_half(KV + tl * KVB, qf, cb, l32, hi); float mx = -INFINITY;
#pragma unroll
              for (int r = 0; r < 16; ++r) { const int c = 64 * tl + 32 * cb + (r & 3) + 8 * (r >> 2) + 4 * hi; const int dist = t - 32 * c - 31; const int dn = dist < 0 ? 0 : (dist > 127 ? 127 : dist);
                  const float y = c < ncv ? S[r] * NSA_C1 + BTh[dn] : -INFINITY; S[r] = y; mx = fmaxf(mx, y); }
              mx = fmaxf(mx, __shfl_xor(mx, 32)); const float mn = fmaxf(m2, mx); lsum *= __builtin_amdgcn_exp2f(m2 - mn); m2 = mn;
#pragma unroll
              for (int r = 0; r < 16; ++r) lsum += __builtin_amdgcn_exp2f(S[r] - m2);
              asm volatile("" ::: "memory"); } }
      lsum += __shfl_xor(lsum, 32); const float inv = 1.f / fmaxf(lsum, 1e-30f);
      LAS float* ih = IMPH + (size_t)(jj * 64 + 32 * qh + l32) * IMPP;
      f32x16_t Oc[2] = {F16Z, F16Z};
#pragma unroll
      for (int tl = 0; tl < 2; ++tl) if (tl < ntile) {
#pragma unroll
          for (int cb = 0; cb < 2; ++cb) { f32x16_t S = nsa_qk_half(KV + tl * KVB, qf, cb, l32, hi);
#pragma unroll
              for (int r = 0; r < 16; ++r) { const int c = 64 * tl + 32 * cb + (r & 3) + 8 * (r >> 2) + 4 * hi; const int dist = t - 32 * c - 31; const int dn = dist < 0 ? 0 : (dist > 127 ? 127 : dist);
                  S[r] = c < ncv ? __builtin_amdgcn_exp2f(S[r] * NSA_C1 + BTh[dn] - m2) * inv : 0.f; }
#pragma unroll
              for (int r = 0; r < 16; r += 2) ih[32 * tl + 16 * cb + 4 * (r >> 2) + 2 * hi + ((r >> 1) & 1)] = S[r] + S[r + 1];
              nsa_pv_half(KV + tl * KVB + KVT, S, Oc, cb, l32, hi);
              asm volatile("" ::: "memory"); } }
      tot[0] = Oc[0] * gc; tot[1] = Oc[1] * gc; }
    __syncthreads();
    for (int i = tid; i < 64 * 64; i += NTHR) { const int q = i >> 6, j = i & 63; IMP[q * IMPP + j] = (IMPH[(0 * 64 + q) * IMPP + j] + IMPH[(1 * 64 + q) * IMPP + j]) + (IMPH[(2 * 64 + q) * IMPP + j] + IMPH[(3 * 64 + q) * IMPP + j]); }
    __syncthreads();
    { const int q = tid >> 3, jg = tid & 7; unsigned byte = 0u;
      if (qt <= 15) { for (int i = 0; i < 8; ++i) if (jg * 8 + i <= qt) byte |= 1u << i; }
      else { const LAS float* iq = IMP + q * IMPP; float v[8]; int rank[8];
#pragma unroll
          for (int i = 0; i < 8; ++i) { v[i] = iq[jg * 8 + i]; rank[i] = 0; }
          for (int k = 0; k < qt; ++k) { const float w = iq[k];
#pragma unroll
              for (int i = 0; i < 8; ++i) rank[i] += (w > v[i] || (w == v[i] && k < jg * 8 + i)) ? 1 : 0; }
#pragma unroll
          for (int i = 0; i < 8; ++i) { const int j = jg * 8 + i; if ((j < qt && rank[i] < 15) || j == qt) byte |= 1u << i; } }
      *((LAS unsigned char*)(lds + NL_SELM) + q * 8 + jg) = (unsigned char)byte; }
    __syncthreads();
    const unsigned long long selm = *(const LAS unsigned long long*)(lds + NL_SELM + (32 * qh + l32) * 8);
    { f32x16_t O[2] = {F16Z, F16Z}; float m = -1e30f, l = 0.f;
      nsa_run_tiles<1>(Z + (size_t)b * TP * NZ + ZC_KV + 256 + g * 64, (const bf16*)(a.ws + WS_SVT) + (size_t)(b * 2 + g) * 64 * TP, KV, 0, qt, qf, O, m, l, qt, t, selm, BTh, bfar, tid, l32, hi);
      l += __shfl_xor(l, 32); const float sc = gs / l; tot[0] += O[0] * sc; tot[1] += O[1] * sc; }
    { f32x16_t O[2] = {F16Z, F16Z}; float m = -1e30f, l = 0.f;
      nsa_run_tiles<2>(Z + (size_t)b * TP * NZ + ZC_WIN + g * 64, (const bf16*)(a.ws + WS_WVT) + (size_t)(b * 2 + g) * 64 * TP, KV, qt >= 8 ? qt - 8 : 0, qt, qf, O, m, l, qt, t, 0ull, BTh, bfar, tid, l32, hi);
      l += __shfl_xor(l, 32); const float sc = gw / l; tot[0] += O[0] * sc; tot[1] += O[1] * sc; }
    { LAS unsigned char* ost = lds + NL_IMPH + wave * 4096;
#pragma unroll
      for (int db = 0; db < 2; ++db)
#pragma unroll
          for (int r4 = 0; r4 < 4; ++r4) { const int d0 = 32 * db + 8 * r4 + 4 * hi; u32x2_t o; o.x = pk2(tot[db][4 * r4], tot[db][4 * r4 + 1]); o.y = pk2(tot[db][4 * r4 + 2], tot[db][4 * r4 + 3]);
              *(LAS u32x2_t*)(ost + l32 * 128 + (((d0 >> 3) ^ (l32 & 7)) << 4) + (d0 & 7) * 2) = o; }
      LDS_WAIT(); asm volatile("" ::: "memory");
      bf16* MIX = (bf16*)(a.ws + WS_MIX) + ((size_t)b * TP + qt * 64 + 32 * qh) * 1024 + 512 + hd * 64;
#pragma unroll
      for (int p = 0; p < 4; ++p) { const int id = p * 64 + lane, q = id >> 3, c8 = id & 7; *(GAS v4u*)(MIX + (size_t)q * 1024 + c8 * 8) = *(const LAS v4u*)(ost + q * 128 + ((c8 ^ (q & 7)) << 4)); } }
    __syncthreads();
}

__device__ __forceinline__ void p4_headnorm(const Args& a, int gw, int NGW, int lane) {
    const bf16* Z = (const bf16*)(a.ws + WS_Z); const float* H = (const float*)(a.ws + WS_H); bf16* MIX = (bf16*)(a.ws + WS_MIX); const float* nw = a.in[I_MNW];
    for (int u = gw + (FAST_MLSTM ? MP * 8 : 0); u < MT * 8; u += NGW) { const int row = u >> 3, hd = u & 7;
        if (row >= MREAL) { MIX[(size_t)row * 1024 + hd * 64 + lane] = 0; MIX[(size_t)row * 1024 + 512 + hd * 64 + lane] = 0; continue; }
        const float hv = H[(size_t)row * 512 + hd * 64 + lane]; const float mu = wave_sum(hv) * (1.f / 64.f); const float dv = hv - mu; const float var = wave_sum(dv * dv) * (1.f / 64.f);
        const float hn = dv * (1.f / sqrtf(var + LN_EPS)) * nw[hd * 64 + lane]; const float o = bf2f(Z[(size_t)row * NZ + ZC_O + hd * 64 + lane]);
        MIX[(size_t)row * 1024 + hd * 64 + lane] = (bf16)f2bf(sigmoidf_(o) * hn); }
}
template <bool FIRST> __device__ __forceinline__ void p_layernorm(const Args& a, int gw, int NGW, int lane) {
    const float* R = (const float*)(a.ws + WS_R); const float* w = a.in[FIRST ? I_LN1W : I_LN2W]; const float* bb = a.in[FIRST ? I_LN1B : I_LN2B];
    for (int m = gw; m < (FIRST ? MT : MREAL); m += NGW) {
        if (FIRST && m >= MREAL) { GAS unsigned long long* o8 = (GAS unsigned long long*)((bf16*)(a.ws + WS_X1B) + (size_t)m * D) + lane; GAS f32x4* o4 = (GAS f32x4*)((float*)(a.ws + WS_X1) + (size_t)m * D) + lane;
#pragma unroll
            for (int j = 0; j < 4; ++j) { o8[64 * j] = 0ull; o4[64 * j] = (f32x4){0.f, 0.f, 0.f, 0.f}; }
            continue; }
        const GAS f32x4* xr = (const GAS f32x4*)(R + (size_t)m * D) + lane; f32x4 v[4]; float s = 0.f;
#pragma unroll
        for (int j = 0; j < 4; ++j) { v[j] = xr[64 * j]; s += (v[j].x + v[j].y) + (v[j].z + v[j].w); }
        const float mean = wave_sum(s) * (1.f / D); float s2 = 0.f;
#pragma unroll
        for (int j = 0; j < 4; ++j) { v[j] = v[j] - mean; s2 += (v[j].x * v[j].x + v[j].y * v[j].y) + (v[j].z * v[j].z + v[j].w * v[j].w); }
        const float rstd = 1.f / sqrtf(wave_sum(s2) * (1.f / D) + LN_EPS);
        float* orow = FIRST ? (float*)(a.ws + WS_X1) + (size_t)m * D : (m < MP ? a.out + O_Y_P + (size_t)m * D : a.out + O_Y_S + (size_t)(m - MP) * D);
#pragma unroll
        for (int j = 0; j < 4; ++j) { const f32x4 ww = *((const GAS f32x4*)w + lane + 64 * j), bv = *((const GAS f32x4*)bb + lane + 64 * j); const f32x4 o = v[j] * rstd * ww + bv;
            *((GAS f32x4*)orow + lane + 64 * j) = o;
            if (FIRST) *((GAS unsigned long long*)((bf16*)(a.ws + WS_X1B) + (size_t)m * D) + lane + 64 * j) = (unsigned long long)pk2(o.x, o.y) | ((unsigned long long)pk2(o.z, o.w) << 32); } }
}
__device__ __forceinline__ void p8_convgate(const Args& a, int gt, int NGT) {
    const bf16* U = (const bf16*)(a.ws + WS_U); bf16* FF = (bf16*)(a.ws + WS_FF); const float* cw = a.in[I_FCW]; const float* cb = a.in[I_FCB]; const float* sfc = a.in[I_SFC];
    for (size_t i = gt; i < (size_t)MT * DFF; i += NGT) { const int row = (int)(i / DFF), c = (int)(i % DFF);
        if (row >= MREAL) { FF[i] = 0; continue; }
        const bool samp = row >= MP; const int b = samp ? (row - MP) >> 2 : row >> 12, t = samp ? (row - MP) & 3 : row & 4095;
        float u2[2];
#pragma unroll
        for (int hh = 0; hh < 2; ++hh) { const int col = c + hh * DFF; float acc = cb[col];
#pragma unroll
            for (int j = 0; j < 3; ++j) { const int tt = t - 2 + j; float v;
                if (tt >= 0) v = bf2f(U[(size_t)(row - 2 + j) * NU + col]); else v = samp ? sfc[(size_t)(b * 2 + 2 + tt) * NU + col] : 0.f;
                acc += cw[j * NU + col] * v; }
            u2[hh] = acc; }
        FF[i] = (bf16)f2bf(gelu_tanh(u2[0]) * u2[1]); }
}

constexpr int LDS_BYTES = 147456, RING_BYTES = 131072, LDSCTL_OFF = RING_BYTES, MISC_OFF = LDSCTL_OFF + 320, AUX_OFF = 132096;
#ifndef NAIVE_GEMM
#define NAIVE_GEMM 0
#endif
__global__ void __launch_bounds__(NTHR, 2) fwd_kernel(Args a) {
    extern __shared__ __attribute__((aligned(16))) unsigned char lds_raw[];
    LAS unsigned char* lds = (LAS unsigned char*)lds_raw;
    volatile LAS unsigned* MISC = (volatile LAS unsigned*)(lds + MISC_OFF);
    const int G = gridDim.x, bx = blockIdx.x; const int vcu = (G % 8 == 0) ? (bx % 8) * (G / 8) + bx / 8 : bx;
    const int NGW = G * NWAVES, NGT = G * NTHR;
#define PHASE_IDS int tid = threadIdx.x; asm volatile("" : "+v"(tid)); const int lane = tid & 63, wave = __builtin_amdgcn_readfirstlane(tid >> 6); const int gw = vcu * NWAVES + wave, gt = vcu * NTHR + tid; (void)lane; (void)gw; (void)gt; (void)wave;
    for (int u = threadIdx.x; u < (LDS_BYTES - LDSCTL_OFF) / 4; u += NTHR) ((LAS unsigned*)(lds + LDSCTL_OFF))[u] = 0u;
    __syncthreads();
    XcdBarrier bar = xcd_barrier_post((unsigned*)(a.ws + WS_CTL) + CW_BAR, MISC + 8);
    unsigned char* ws = a.ws;

    { PHASE_IDS p0_prologue(a, lds, gw, NGW, gt, NGT, wave, lane); }
    xcd_barrier(bar);
    { pg8::Gemm g{(const pg8::bf16_t*)(ws + WS_XB), (const pg8::bf16_t*)(ws + WS_WIN_T), MT, NZ, D}; pg8::StaticOrder S; S.init(MT, NZ, G, bx);
      EpiZ E{a.out, ws}; pg8::gemm_phase<EpiZ, pg8::StaticOrder, PG8_ALIGN, PG8_SP2>(lds, g, S, E); }
    xcd_barrier(bar);
    { PHASE_IDS p2_conv_pool(a, gw, NGW, gt, NGT, lane); p2_vtrans(a, lds + wave * 8192, gw, NGW, lane); }
    xcd_barrier(bar);
#if FAST_MLSTM
    { PHASE_IDS
      for (int u = bx; u < BS * 8; u += G) mlstm_chain(a, true, u >> 3, u & 7, tid);
      for (int u = gw; u < BP * 8 * 64; u += NGW) mlstm_passA(a, lds + wave * 16384, (LAS float*)(lds + AUX_OFF + wave * 256), u, lane); }
    xcd_barrier(bar);
    { PHASE_IDS mlstm_scan(a, gt, NGT); }
    xcd_barrier(bar);
    { PHASE_IDS for (int u = gw; u < BP * 8 * 64; u += NGW) mlstm_passC(a, lds + wave * 16384, u, lane); }
    __syncthreads();
#else
    { PHASE_IDS for (int u = bx; u < BP * 8 + BS * 8; u += G) { if (u < BP * 8) mlstm_chain(a, false, u >> 3, u & 7, tid); else mlstm_chain(a, true, (u - BP * 8) >> 3, (u - BP * 8) & 7, tid); } }
#endif
    { PHASE_IDS const NsaLds L = nsa_lds(lds); nsa_bias_table(a, L, tid);
      for (int u = bx; u < MS * 2; u += G) { const int b = u >> 3, g = (u >> 2) & 1, tl = u & 3; nsa_unit(a, L, true, b, g, tl, tid, wave, lane); }
#if FAST_NSA
      __syncthreads();
      for (int i = tid; i < 1024; i += NTHR) L.BT[i] *= 1.4426950408889634f;
      __syncthreads();
      for (int u = vcu; u < BP * 2 * 32; u += G) { const int b = u >> 6, g = (u >> 5) & 1, s = u & 31;
#pragma unroll 1
          for (int i = 0; i < 2; ++i) nsa_p_unit(a, lds, b, g, i ? 63 - s : s, tid, wave); }
#else
      for (int u = bx; u < MP * 2; u += G) { const int b = u >> 13, g = (u >> 12) & 1, tl = u & 4095; nsa_unit(a, L, false, b, g, tl, tid, wave, lane); }
#endif
    }
    xcd_barrier(bar);
    { PHASE_IDS p4_headnorm(a, gw, NGW, lane); }
    xcd_barrier(bar);
    { pg8::Gemm g{(const pg8::bf16_t*)(ws + WS_MIX), (const pg8::bf16_t*)(ws + WS_WOUT_T), MT, D, D}; pg8::StaticOrder S; S.init(MT, D, G, bx);
      EpiRes<true> E{a.in[I_XP], a.in[I_XS], nullptr, nullptr, (float*)(ws + WS_R)}; pg8::gemm_phase<EpiRes<true>, pg8::StaticOrder, PG8_ALIGN, PG8_SP2>(lds, g, S, E); }
    xcd_barrier(bar);
    { PHASE_IDS p_layernorm<true>(a, gw, NGW, lane); }
    xcd_barrier(bar);
    { pg8::Gemm g{(const pg8::bf16_t*)(ws + WS_X1B), (const pg8::bf16_t*)(ws + WS_WUP_T), MT, NU, D}; pg8::StaticOrder S; S.init(MT, NU, G, bx);
      EpiU E{a.out, ws, a.in[I_BUP]}; pg8::gemm_phase<EpiU, pg8::StaticOrder, PG8_ALIGN, PG8_SP2>(lds, g, S, E); }
    xcd_barrier(bar);
    { PHASE_IDS p8_convgate(a, gt, NGT); }
    xcd_barrier(bar);
    { pg8::Gemm g{(const pg8::bf16_t*)(ws + WS_FF), (const pg8::bf16_t*)(ws + WS_WDN_T), MT, D, DFF}; pg8::StaticOrder S; S.init(MT, D, G, bx);
      EpiRes<false> E{nullptr, nullptr, (const float*)(ws + WS_X1), a.in[I_BDN], (float*)(ws + WS_R)}; pg8::gemm_phase<EpiRes<false>, pg8::StaticOrder, PG8_ALIGN, PG8_SP2>(lds, g, S, E); }
    xcd_barrier(bar);
    { PHASE_IDS p_layernorm<false>(a, gw, NGW, lane); }
}

extern "C" void kernel_launch(void* const* d_in, const int* in_sizes, int n_in, void* d_out, int out_size, void* d_ws, size_t ws_size, hipStream_t stream) {
    static int grid = 0;
    if (grid == 0) {
        if (n_in != N_IN || out_size != (int)O_END || ws_size < WS_END) { fprintf(stderr, "kernel_launch: unexpected shapes: n_in %d out %d ws %zu\n", n_in, out_size, ws_size); grid = -1; return; }
        int dev = 0, cus = 0, per_cu = 0;
        if (hipGetDevice(&dev) != hipSuccess || hipDeviceGetAttribute(&cus, hipDeviceAttributeMultiprocessorCount, dev) != hipSuccess) { grid = -1; return; }
        if (hipFuncSetAttribute((const void*)fwd_kernel, hipFuncAttributeMaxDynamicSharedMemorySize, LDS_BYTES) != hipSuccess) { fprintf(stderr, "kernel_launch: hipFuncSetAttribute failed\n"); grid = -1; return; }
        if (hipOccupancyMaxActiveBlocksPerMultiprocessor(&per_cu, (const void*)fwd_kernel, NTHR, LDS_BYTES) != hipSuccess || per_cu < 1) { fprintf(stderr, "kernel_launch: occupancy query says %d\n", per_cu); }
        (void)hipGetLastError();
        grid = cus;
    }
    if (grid < 0) return;
    if (hipMemsetAsync((char*)d_ws + WS_CTL, 0, CTL_ZERO_BYTES, stream) != hipSuccess) return;
    Args a{};
    for (int i = 0; i < N_IN; ++i) a.in[i] = (const float*)d_in[i];
    a.out = (float*)d_out; a.ws = (unsigned char*)d_ws;
    hipLaunchKernelGGL(fwd_kernel, dim3(grid), dim3(NTHR), LDS_BYTES, stream, a);
}
```
